# Optimizing an MI355X kernel written in HIP

```python
import jax, jax.numpy as jnp
from jax import lax
import numpy as np

D_MODEL = 1024
BATCH = 16
SEQ = 2048
DEPTH = 1
DEC_BATCH = 32
DEC_SEQ = 4
PAST_LEN = 16384
PAGE_SIZE = 128

R_HEAD_DIM = 64
R_WIDTH = D_MODEL // 2
R_HEADS = R_WIDTH // R_HEAD_DIM
DECAY_LORA = 64
AAA_LORA = 64
R_SHIFT_WIDTH = 3 * R_WIDTH + DECAY_LORA + AAA_LORA
N_HEAD_DIM = 64
N_WIDTH = D_MODEL - R_WIDTH
N_HEADS = N_WIDTH // N_HEAD_DIM
N_KV_HEADS = 2
N_GROUP = N_HEADS // N_KV_HEADS
N_BRANCH = 3
KV_SLOTS = 2 * N_BRANCH
CMP_BLOCK = 32
CMP_STRIDE = 16
SEL_BLOCK = 64
SEL_TOPK = 16
WINDOW = 512
SEL_QUERY_BLOCK = 32
WIN_QUERY_BLOCK = 128
MIX_WIDTH = R_WIDTH + N_WIDTH
PROJ_SPLITS = (R_SHIFT_WIDTH, R_WIDTH, N_WIDTH, N_WIDTH, KV_SLOTS * N_KV_HEADS * N_HEAD_DIM, N_BRANCH * N_HEADS)
PROJ_WIDTH = sum(PROJ_SPLITS)
RMS_EPS = 1e-6
GN_EPS = 64e-5
MASK_NEG = -1e30
SEL_BIAS = 1e4
ATTN_SCALE = N_HEAD_DIM ** -0.5

kernel_name = 'hymba_rwkv7_nsa_decode_step'


def rms_norm(x, g):
    xf = x.astype(jnp.float32)
    y = xf * lax.rsqrt(jnp.mean(xf * xf, axis=-1, keepdims=True) + RMS_EPS)
    return (y * g.astype(jnp.float32)).astype(x.dtype)


def masked_softmax(s, mask):
    s = jnp.where(mask, s.astype(jnp.float32), MASK_NEG)
    p = jax.nn.softmax(s, axis=-1)
    return jnp.where(mask, p, 0.0)


def split_proj(p):
    offs = np.cumsum((0,) + PROJ_SPLITS)
    return tuple(p[..., int(offs[i]):int(offs[i + 1])] for i in range(len(PROJ_SPLITS)))


def to_heads(q):
    B, T, _ = q.shape
    return q.reshape(B, T, N_KV_HEADS, N_GROUP, N_HEAD_DIM).transpose(0, 2, 3, 1, 4)


def rwkv_mix(z, z_prev, s0, gate, mu_shift, w0, w_decay_up, a0, w_aaa_up, k_k, k_a, r_k, gn_w, gn_b):
    B, T, _ = z.shape
    f32 = jnp.float32
    zp = jnp.concatenate([z_prev[:, None].astype(z.dtype), z[:, :-1]], axis=1)
    zs = z + (zp - z) * mu_shift
    r, k, v, wd, ad = jnp.split(zs, [R_WIDTH, 2 * R_WIDTH, 3 * R_WIDTH, 3 * R_WIDTH + DECAY_LORA], axis=-1)
    w_log = -jax.nn.softplus(-(w0 + jnp.tanh(wd) @ w_decay_up).astype(f32)) - 0.5
    decay = jnp.exp(-jnp.exp(w_log))
    a = jax.nn.sigmoid((a0 + ad @ w_aaa_up).astype(f32))
    hs = (B, T, R_HEADS, R_HEAD_DIM)
    r, k, v, decay, a = (t.astype(f32).reshape(hs) for t in (r, k, v, decay, a))
    hshape = (R_HEADS, R_HEAD_DIM)
    kk = k * k_k.astype(f32).reshape(hshape)
    kk = kk * lax.rsqrt(jnp.maximum(jnp.sum(kk * kk, axis=-1, keepdims=True), 1e-24))
    k = k * (1.0 + (a - 1.0) * k_a.astype(f32).reshape(hshape))

    def step(S, inp):
        r_t, w_t, k_t, v_t, kk_t, a_t = inp
        sa = jnp.einsum('bhij,bhj->bhi', S, kk_t)
        S = (S * w_t[:, :, None, :] - sa[..., None] * (kk_t * a_t)[:, :, None, :]
             + v_t[..., None] * k_t[:, :, None, :])
        return S, jnp.einsum('bhij,bhj->bhi', S, r_t)

    s_fin, y = lax.scan(step, s0.astype(f32), tuple(jnp.moveaxis(t, 1, 0) for t in (r, decay, k, v, kk, a)))
    y = jnp.moveaxis(y, 0, 1)
    yc = y - jnp.mean(y, axis=-1, keepdims=True)
    y = yc * lax.rsqrt(jnp.mean(yc * yc, axis=-1, keepdims=True) + GN_EPS)
    y = y * gn_w.astype(f32).reshape(hshape) + gn_b.astype(f32).reshape(hshape)
    y = y + jnp.sum(r * k * r_k.astype(f32).reshape(hshape), axis=-1, keepdims=True) * v
    out = y.reshape(B, T, R_WIDTH).astype(z.dtype) * jax.nn.silu(gate)
    return out, s_fin, z[:, -1]


def compress(kv, w_pos, w_mix):
    B, L = kv.shape[:2]
    n_sub = CMP_BLOCK // CMP_STRIDE
    n_chunk = L // CMP_STRIDE
    n_cmp = n_chunk - n_sub + 1
    c = kv[:, :n_chunk * CMP_STRIDE].reshape(B, n_chunk, CMP_STRIDE, 2, N_KV_HEADS, N_HEAD_DIM)
    wp = w_pos.reshape(2, n_sub, CMP_STRIDE, N_HEAD_DIM)
    pooled = jnp.einsum('bjpekd,epd->bjekd', c[:, 0:n_cmp], wp[:, 0])
    for m in range(1, n_sub):
        pooled = pooled + jnp.einsum('bjpekd,epd->bjekd', c[:, m:m + n_cmp], wp[:, m])
    return jnp.einsum('bjekd,edf->bjekf', pooled, w_mix)


def compressed_attn(q, kc, qpos):
    n_cmp = kc.shape[1]
    kend = jnp.arange(n_cmp) * CMP_STRIDE + (CMP_BLOCK - 1)
    mask = kend[None, :] <= qpos[:, None]
    s = jnp.einsum('bkgtd,bjkd->bkgtj', q, kc[:, :, 0]) * ATTN_SCALE
    p = masked_softmax(s, mask)
    o = jnp.einsum('bkgtj,bjkd->bkgtd', p.astype(q.dtype), kc[:, :, 1])
    return o, jnp.sum(p, axis=2)


def select_blocks(imp, qpos, total_len):
    n_cmp = imp.shape[-1]
    n_sel = -(-total_len // SEL_BLOCK)
    cs = jnp.arange(n_cmp) * CMP_STRIDE
    ss = jnp.arange(n_sel) * SEL_BLOCK
    overlap = ((cs[:, None] < ss[None, :] + SEL_BLOCK) & (cs[:, None] + CMP_BLOCK > ss[None, :])).astype(jnp.float32)
    score = jnp.einsum('bktj,js->bkts', imp, overlap)
    cur = (qpos // SEL_BLOCK)[:, None]
    sid = jnp.arange(n_sel)[None, :]
    valid = sid <= cur
    forced = (sid == 0) | (sid == cur) | (sid == cur - 1)
    score = jnp.where(valid, score + jnp.where(forced, SEL_BIAS, 0.0), -SEL_BIAS)
    vals, idx = lax.top_k(score, min(SEL_TOPK, n_sel))
    return idx, vals > -0.5 * SEL_BIAS


def selected_attn(q, ks, vs, idx, valid, qpos):
    B, KV, T, K = idx.shape
    kpos = idx[..., None] * SEL_BLOCK + jnp.arange(SEL_BLOCK)
    mask = (valid[..., None] & (kpos <= qpos[:, None, None])).reshape(B, KV, 1, T, K * SEL_BLOCK)
    ks = ks.reshape(B, KV, T, K * SEL_BLOCK, N_HEAD_DIM)
    vs = vs.reshape(B, KV, T, K * SEL_BLOCK, N_HEAD_DIM)
    s = jnp.einsum('bkgtd,bktnd->bkgtn', q, ks) * ATTN_SCALE
    p = masked_softmax(s, mask)
    return jnp.einsum('bkgtn,bktnd->bkgtd', p.astype(q.dtype), vs)


def selected_prompt_attn(q, kv_sel, idx, valid, qpos):
    B, T = kv_sel.shape[:2]
    n_sel = T // SEL_BLOCK
    blocks = kv_sel.reshape(B, n_sel, SEL_BLOCK, 2, N_KV_HEADS, N_HEAD_DIM).transpose(0, 4, 1, 2, 3, 5)
    bk, bv = blocks[..., 0, :], blocks[..., 1, :]
    bi = jnp.arange(B)[:, None, None, None]
    gi = jnp.arange(N_KV_HEADS)[None, :, None, None]
    nq = T // SEL_QUERY_BLOCK

    def split(t, ax):
        return jnp.moveaxis(t.reshape(t.shape[:ax] + (nq, SEL_QUERY_BLOCK) + t.shape[ax + 1:]), ax, 0)

    def chunk(args):
        qc, ic, vc, pc = args
        return selected_attn(qc, bk[bi, gi, ic], bv[bi, gi, ic], ic, vc, pc)

    out = lax.map(chunk, (split(q, 3), split(idx, 2), split(valid, 2), qpos.reshape(nq, SEL_QUERY_BLOCK)))
    return jnp.moveaxis(out, 0, 3).reshape(B, N_KV_HEADS, N_GROUP, T, N_HEAD_DIM)


def selected_sample_attn(q, kv_new, cache, page_table, idx, valid, qpos):
    B, T = kv_new.shape[:2]
    bpp = PAGE_SIZE // SEL_BLOCK
    n_past = page_table.shape[1] * bpp
    pool = cache.reshape(cache.shape[0] * bpp, SEL_BLOCK, cache.shape[2], N_KV_HEADS, N_HEAD_DIM)
    n_tail = -(-T // SEL_BLOCK)
    tail = jnp.pad(kv_new, ((0, 0), (0, n_tail * SEL_BLOCK - T), (0, 0), (0, 0), (0, 0)))
    tail = tail.reshape(B, n_tail, SEL_BLOCK, 2, N_KV_HEADS, N_HEAD_DIM).transpose(0, 4, 1, 2, 3, 5)
    bi = jnp.arange(B)[:, None, None, None]
    gi = jnp.arange(N_KV_HEADS)[None, :, None, None]
    ip = jnp.minimum(idx, n_past - 1)
    phys = page_table[bi, ip // bpp] * bpp + ip % bpp
    past_rows = pool[phys, :, 2:4, gi]
    tail_rows = tail[bi, gi, jnp.clip(idx - n_past, 0, n_tail - 1)]
    rows = jnp.where((idx < n_past)[..., None, None, None], past_rows.astype(tail_rows.dtype), tail_rows)
    return selected_attn(q, rows[..., 0, :], rows[..., 1, :], idx, valid, qpos)


def window_attn(q, kw, qpos, kpos):
    mask = (kpos[None, :] <= qpos[:, None]) & (kpos[None, :] > qpos[:, None] - WINDOW) & (kpos[None, :] >= 0)
    s = jnp.einsum('bkgtd,bskd->bkgts', q, kw[:, :, 0]) * ATTN_SCALE
    p = masked_softmax(s, mask)
    return jnp.einsum('bkgts,bskd->bkgtd', p.astype(q.dtype), kw[:, :, 1])


def window_prompt_attn(q, kv_win):
    B, T = kv_win.shape[:2]
    padded = jnp.pad(kv_win, ((0, 0), (WINDOW, 0), (0, 0), (0, 0), (0, 0)))
    nq = T // WIN_QUERY_BLOCK

    def chunk(i):
        start = i * WIN_QUERY_BLOCK
        kw = lax.dynamic_slice_in_dim(padded, start, WINDOW + WIN_QUERY_BLOCK, axis=1)
        qc = lax.dynamic_slice_in_dim(q, start, WIN_QUERY_BLOCK, axis=3)
        qpos = start + jnp.arange(WIN_QUERY_BLOCK)
        kpos = start - WINDOW + jnp.arange(WINDOW + WIN_QUERY_BLOCK)
        return window_attn(qc, kw, qpos, kpos)

    out = lax.map(chunk, jnp.arange(nq))
    return jnp.moveaxis(out, 0, 3).reshape(B, N_KV_HEADS, N_GROUP, T, N_HEAD_DIM)


def mixer_out(y_r, o_c, o_s, o_w, gl, gate_n, w_out):
    B, T, _ = y_r.shape
    g = jax.nn.sigmoid(gl.astype(jnp.float32)).reshape(B, T, N_BRANCH, N_KV_HEADS, N_GROUP)
    g = g.transpose(2, 0, 3, 4, 1)[..., None]
    o = g[0] * o_c + g[1] * o_s + g[2] * o_w
    o = o.transpose(0, 3, 1, 2, 4).reshape(B, T, N_WIDTH).astype(y_r.dtype) * jax.nn.silu(gate_n)
    return jnp.concatenate([y_r, o], axis=-1) @ w_out


def prompt_layer(x, norm_g, w_in, mu_shift, w0, w_decay_up, a0, w_aaa_up, k_k, k_a, r_k, gn_w, gn_b,
                 w_cmp_pos, w_cmp_mix, w_out):
    B, T, _ = x.shape
    zr, gate_r, q, gate_n, kv, gl = split_proj(rms_norm(x, norm_g) @ w_in)
    y_r, wkv, shift = rwkv_mix(zr, jnp.zeros((B, R_SHIFT_WIDTH), zr.dtype),
                               jnp.zeros((B, R_HEADS, R_HEAD_DIM, R_HEAD_DIM), jnp.float32), gate_r,
                               mu_shift, w0, w_decay_up, a0, w_aaa_up, k_k, k_a, r_k, gn_w, gn_b)
    kv = kv.reshape(B, T, KV_SLOTS, N_KV_HEADS, N_HEAD_DIM)
    qh = to_heads(q)
    qpos = jnp.arange(T)
    o_c, imp = compressed_attn(qh, compress(kv[:, :, 0:2], w_cmp_pos, w_cmp_mix), qpos)
    idx, valid = select_blocks(imp, qpos, T)
    o_s = selected_prompt_attn(qh, kv[:, :, 2:4], idx, valid, qpos)
    o_w = window_prompt_attn(qh, kv[:, :, 4:6])
    y = x + mixer_out(y_r, o_c, o_s, o_w, gl, gate_n, w_out)
    return y, kv[:, :, 0:4], kv[:, T - min(WINDOW, T):, 4:6], wkv, shift


def sample_layer(x, cache, win_buf, wkv0, shift0, page_table, norm_g, w_in, mu_shift, w0, w_decay_up, a0,
                 w_aaa_up, k_k, k_a, r_k, gn_w, gn_b, w_cmp_pos, w_cmp_mix, w_out):
    B, T, _ = x.shape
    past = page_table.shape[1] * PAGE_SIZE
    zr, gate_r, q, gate_n, kv, gl = split_proj(rms_norm(x, norm_g) @ w_in)
    y_r, wkv, shift = rwkv_mix(zr, shift0, wkv0, gate_r,
                               mu_shift, w0, w_decay_up, a0, w_aaa_up, k_k, k_a, r_k, gn_w, gn_b)
    kv = kv.reshape(B, T, KV_SLOTS, N_KV_HEADS, N_HEAD_DIM)
    qh = to_heads(q)
    qpos = past + jnp.arange(T)
    past_cmp = cache[page_table, :, 0:2].reshape(B, past, 2, N_KV_HEADS, N_HEAD_DIM)
    full_cmp = jnp.concatenate([past_cmp.astype(kv.dtype), kv[:, :, 0:2]], axis=1)
    o_c, imp = compressed_attn(qh, compress(full_cmp, w_cmp_pos, w_cmp_mix), qpos)
    idx, valid = select_blocks(imp, qpos, past + T)
    o_s = selected_sample_attn(qh, kv[:, :, 2:4], cache, page_table, idx, valid, qpos)
    nb = win_buf.shape[1]
    keys_w = jnp.concatenate([win_buf.astype(kv.dtype), kv[:, :, 4:6]], axis=1)
    o_w = window_attn(qh, keys_w, qpos, past - nb + jnp.arange(nb + T))
    y = x + mixer_out(y_r, o_c, o_s, o_w, gl, gate_n, w_out)
    n_keep = min(WINDOW, nb + T)
    return y, kv[:, :, 0:4], keys_w[:, nb + T - n_keep:], wkv, shift


def setup_inputs(seed: int = 0) -> dict:
    key = jax.random.key(seed)
    k = jax.random.split(key, 24)
    f32 = jnp.float32

    def nrm(i, shape, scale):
        return scale * jax.random.normal(k[i], shape, f32)

    n_pages = PAST_LEN // PAGE_SIZE
    n_phys = (5 * DEC_BATCH * n_pages) // 4
    win_len = min(WINDOW, PAST_LEN)
    hd = N_HEAD_DIM
    page_table = jax.random.permutation(k[6], n_phys)[:DEC_BATCH * n_pages].reshape(DEC_BATCH, n_pages).astype(jnp.int32)
    return {
        'x_prompt': nrm(0, (BATCH, SEQ, D_MODEL), 1.0),
        'x_sample': nrm(1, (DEC_BATCH, DEC_SEQ, D_MODEL), 1.0),
        'cache_kv': nrm(2, (DEPTH, n_phys, PAGE_SIZE, 4, N_KV_HEADS, hd), 1.0),
        'cache_kv_win': nrm(3, (DEPTH, DEC_BATCH, win_len, 2, N_KV_HEADS, hd), 1.0),
        'state_wkv': nrm(4, (DEPTH, DEC_BATCH, R_HEADS, R_HEAD_DIM, R_HEAD_DIM), 0.5),
        'state_shift': nrm(5, (DEPTH, DEC_BATCH, R_SHIFT_WIDTH), 1.0),
        'page_table': page_table,
        'norm_g': 1.0 + nrm(7, (DEPTH, D_MODEL), 0.02),
        'w_in': nrm(8, (DEPTH, D_MODEL, PROJ_WIDTH), D_MODEL ** -0.5),
        'mu_shift': jax.random.uniform(k[9], (DEPTH, R_SHIFT_WIDTH), f32),
        'w0': nrm(10, (DEPTH, R_WIDTH), 0.5),
        'w_decay_up': nrm(11, (DEPTH, DECAY_LORA, R_WIDTH), 0.1),
        'a0': nrm(12, (DEPTH, R_WIDTH), 0.1),
        'w_aaa_up': nrm(13, (DEPTH, AAA_LORA, R_WIDTH), AAA_LORA ** -0.5),
        'k_k': 0.85 + nrm(14, (DEPTH, R_WIDTH), 0.02),
        'k_a': 1.0 + nrm(15, (DEPTH, R_WIDTH), 0.02),
        'r_k': nrm(16, (DEPTH, R_WIDTH), 0.1),
        'gn_w': 1.0 + nrm(17, (DEPTH, R_WIDTH), 0.02),
        'gn_b': nrm(18, (DEPTH, R_WIDTH), 0.02),
        'w_cmp_pos': (1.0 + nrm(19, (DEPTH, 2, CMP_BLOCK, hd), 0.1)) * CMP_BLOCK ** -0.5,
        'w_cmp_mix': nrm(20, (DEPTH, 2, hd, hd), hd ** -0.5),
        'w_out': nrm(21, (DEPTH, MIX_WIDTH, D_MODEL), MIX_WIDTH ** -0.5),
        'final_g': 1.0 + nrm(22, (D_MODEL,), 0.02),
    }


def reference(x_prompt, x_sample, cache_kv, cache_kv_win, state_wkv, state_shift, page_table,
              norm_g, w_in, mu_shift, w0, w_decay_up, a0, w_aaa_up, k_k, k_a, r_k, gn_w, gn_b,
              w_cmp_pos, w_cmp_mix, w_out, final_g):
    y_p, y_s = x_prompt, x_sample
    kvp, kvs, wnp, wns, skp, sks, shp, shs = [], [], [], [], [], [], [], []
    for layer in range(DEPTH):
        lw = (norm_g[layer], w_in[layer], mu_shift[layer], w0[layer], w_decay_up[layer], a0[layer],
              w_aaa_up[layer], k_k[layer], k_a[layer], r_k[layer], gn_w[layer], gn_b[layer],
              w_cmp_pos[layer], w_cmp_mix[layer], w_out[layer])
        y_p, p_kv, p_win, p_wkv, p_shift = prompt_layer(y_p, *lw)
        y_s, s_kv, s_win, s_wkv, s_shift = sample_layer(y_s, cache_kv[layer], cache_kv_win[layer],
                                                        state_wkv[layer], state_shift[layer], page_table, *lw)
        kvp.append(p_kv); kvs.append(s_kv); wnp.append(p_win); wns.append(s_win)
        skp.append(p_wkv); sks.append(s_wkv); shp.append(p_shift); shs.append(s_shift)
    y_prompt = rms_norm(y_p, final_g)
    y_sample = rms_norm(y_s, final_g)
    kv_prompt = jnp.stack(kvp)
    kv_sample = jnp.stack(kvs)
    win_prompt = jnp.stack(wnp)
    win_sample = jnp.stack(wns)
    wkv_prompt = jnp.stack(skp)
    wkv_sample = jnp.stack(sks)
    shift_prompt = jnp.stack(shp)
    shift_sample = jnp.stack(shs)
    return (y_prompt, y_sample, kv_prompt, kv_sample, win_prompt, win_sample, wkv_prompt, wkv_sample, shift_prompt, shift_sample)
```

```cpp
#include <hip/hip_runtime.h>
#include <cstdint>
#include <cstdio>
#include <cmath>

#ifndef DUPMASK
#define DUPMASK 0
#endif
#ifndef MK_N_LAUNCHES
#define MK_N_LAUNCHES 1
#endif

constexpr int DM = 1024, BATCH = 16, SEQ = 2048, DECB = 32, DECT = 4, PAST = 16384;
constexpr int MP = BATCH * SEQ;
constexpr int MS = DECB * DECT;
constexpr int MTOT = MP + MS;
constexpr int MPAD = 33024;
constexpr int NPROJ = 3992, NP = 4096;
constexpr int ZW = 1664;
constexpr int C_R = 0, C_K = 512, C_V = 1024, C_WD = 1536, C_AD = 1600, C_GL = 1664, C_GR = 1792, C_Q = 2304, C_GN = 2816, C_KV = 3328;
constexpr float QSCALE = 0.125f * 1.4426950408889634f;
constexpr size_t O_YP = 0;
constexpr size_t O_YS = O_YP + (size_t)MP * DM;
constexpr size_t O_KVP = O_YS + (size_t)MS * DM;
constexpr size_t O_KVS = O_KVP + (size_t)MP * 512;
constexpr size_t O_WINP = O_KVS + (size_t)MS * 512;
constexpr size_t O_WINS = O_WINP + (size_t)BATCH * 512 * 256;
constexpr size_t O_WKVP = O_WINS + (size_t)DECB * 512 * 256;
constexpr size_t O_WKVS = O_WKVP + (size_t)BATCH * 8 * 64 * 64;
constexpr size_t O_SHP = O_WKVS + (size_t)DECB * 8 * 64 * 64;
constexpr size_t O_SHS = O_SHP + (size_t)BATCH * ZW;
constexpr size_t O_END = O_SHS + (size_t)DECB * ZW;
static_assert(O_END == 58472448, "output size");
constexpr size_t MiB = 1u << 20;
constexpr size_t WS_CTL = 0, CTL_BYTES = 65536;
constexpr size_t WS_WINT = 1 * MiB, WS_WOUT = 9 * MiB, WS_RS = 11 * MiB;
constexpr size_t WS_CMPK_P = 12 * MiB, WS_CMPV_P = 12 * MiB + 512 * 1024, WS_CMPK_S = 13 * MiB, WS_CMPV_S = 21 * MiB, WS_BONUS = 29 * MiB;
constexpr size_t WS_WDUT = 31 * MiB, WS_WAUT = 31 * MiB + 128 * 1024;
constexpr size_t WS_XB = 32 * MiB, WS_MIX = 98 * MiB, WS_PJ = 164 * MiB, WS_RW = 424 * MiB, RW_STRIDE = 1 * MiB, WS_CHK = 432 * MiB, CHK_BYTES = 32768, WS_S0 = 640 * MiB, WS_YB = 680 * MiB, WS_END = 750 * MiB;
constexpr int LDS_BYTES = 147456;
constexpr int MISC_OFF = LDS_BYTES - 256;

#define LAS __attribute__((address_space(3)))
typedef unsigned short bf16_t;
typedef unsigned u32x4 __attribute__((ext_vector_type(4)));
typedef unsigned u32x2 __attribute__((ext_vector_type(2)));
typedef float f32x4 __attribute__((ext_vector_type(4)));
typedef float f32x16 __attribute__((ext_vector_type(16)));
typedef short bf16x8 __attribute__((ext_vector_type(8)));
typedef short s16x4 __attribute__((ext_vector_type(4)));
typedef float f32x2_t __attribute__((ext_vector_type(2)));
typedef __bf16 bf16x2_t __attribute__((ext_vector_type(2)));

__device__ __forceinline__ unsigned cvtpk(float lo, float hi) { f32x2_t v = {lo, hi}; bf16x2_t b = __builtin_convertvector(v, bf16x2_t); return __builtin_bit_cast(unsigned, b); }
__device__ __forceinline__ float bf2f(unsigned short u) { return __uint_as_float(((unsigned)u) << 16); }
__device__ __forceinline__ float bflo(unsigned w) { return __uint_as_float(w << 16); }
__device__ __forceinline__ float bfhi(unsigned w) { return __uint_as_float(w & 0xffff0000u); }
__device__ __forceinline__ unsigned short f2bf(float f) { return (unsigned short)(cvtpk(f, 0.f) & 0xffffu); }
__device__ __forceinline__ float wave_sum(float v) {
#pragma unroll
    for (int o = 1; o < 64; o <<= 1) v += __shfl_xor(v, o);
    return v;
}
__device__ __forceinline__ float wave_max(float v) {
#pragma unroll
    for (int o = 1; o < 64; o <<= 1) v = fmaxf(v, __shfl_xor(v, o));
    return v;
}
__device__ __forceinline__ float dpp_f(float v, int) { return v; }
#define DPPF(v, ctrl) __builtin_bit_cast(float, __builtin_amdgcn_update_dpp(0, __builtin_bit_cast(int, (v)), (ctrl), 0xF, 0xF, true))
__device__ __forceinline__ float wave_sum_dpp(float v) {
    v += DPPF(v, 0xB1); v += DPPF(v, 0x4E); v += DPPF(v, 0x141); v += DPPF(v, 0x140);
    const int iv = __builtin_bit_cast(int, v);
    const float r0 = __builtin_bit_cast(float, __builtin_amdgcn_readlane(iv, 0)), r1 = __builtin_bit_cast(float, __builtin_amdgcn_readlane(iv, 16));
    const float r2 = __builtin_bit_cast(float, __builtin_amdgcn_readlane(iv, 32)), r3 = __builtin_bit_cast(float, __builtin_amdgcn_readlane(iv, 48));
    return (r0 + r1) + (r2 + r3);
}
__device__ __forceinline__ float wave_max_dpp(float v) {
    v = fmaxf(v, DPPF(v, 0xB1)); v = fmaxf(v, DPPF(v, 0x4E)); v = fmaxf(v, DPPF(v, 0x141)); v = fmaxf(v, DPPF(v, 0x140));
    const int iv = __builtin_bit_cast(int, v);
    const float r0 = __builtin_bit_cast(float, __builtin_amdgcn_readlane(iv, 0)), r1 = __builtin_bit_cast(float, __builtin_amdgcn_readlane(iv, 16));
    const float r2 = __builtin_bit_cast(float, __builtin_amdgcn_readlane(iv, 32)), r3 = __builtin_bit_cast(float, __builtin_amdgcn_readlane(iv, 48));
    return fmaxf(fmaxf(r0, r1), fmaxf(r2, r3));
}
#define LDS_BAR() do { asm volatile("s_waitcnt lgkmcnt(0)" ::: "memory"); __builtin_amdgcn_s_barrier(); asm volatile("" ::: "memory"); } while (0)
__device__ __forceinline__ float fexp(float x) { return __expf(x); }
__device__ __forceinline__ float fsigm(float x) { return __builtin_amdgcn_rcpf(1.f + __expf(-x)); }
__device__ __forceinline__ float fsilu(float x) { return x * __builtin_amdgcn_rcpf(1.f + __expf(-x)); }
__device__ __forceinline__ float ftanh(float x) { return 1.f - 2.f * __builtin_amdgcn_rcpf(1.f + __expf(2.f * x)); }
__device__ __forceinline__ float sigm(float x) { return 1.f / (1.f + expf(-x)); }
__device__ __forceinline__ float silu(float x) { return x / (1.f + expf(-x)); }
__device__ __forceinline__ void unpack8(const u32x4 w, float* f) {
    f[0] = bflo(w.x); f[1] = bfhi(w.x); f[2] = bflo(w.y); f[3] = bfhi(w.y); f[4] = bflo(w.z); f[5] = bfhi(w.z); f[6] = bflo(w.w); f[7] = bfhi(w.w);
}

namespace pg8 {
#define PG8_LAS __attribute__((address_space(3)))
typedef unsigned short bf16_t;
typedef short bf16x8 __attribute__((ext_vector_type(8)));
typedef float f32x4 __attribute__((ext_vector_type(4)));
typedef unsigned u32x4 __attribute__((ext_vector_type(4)));
constexpr int BM = 256, BK = 64, HALF = 128, HTB = HALF * BK * 2  , STAGE_BYTES = 8 * HTB, NXCD = 8, WGM = 8;

__host__ __device__ __forceinline__ int lds_byte(int r, int c) { const int st = (r >> 4) * 2 + (c >> 5), rr = r & 15, cc = c & 31, ob = rr * 64 + cc * 2; return st * 1024 + (ob ^ (((ob >> 9) & 1) << 5)); }
__host__ __device__ __forceinline__ void stage_rc(int b, int& R, int& C) { const int st = b / 1024, sb = b % 1024, swz = sb ^ (((sb >> 9) & 1) << 5); R = (st >> 1) * 16 + swz / 64; C = (st & 1) * 32 + (swz % 64) / 2; }
__host__ __device__ __forceinline__ int perm32(int rho) { const int n = rho >> 4, i = rho & 15; return 8 * (i >> 2) + 4 * n + (i & 3); }

struct Unit { int pm, pn; };
struct Gemm { const bf16_t* A; const bf16_t* Bt; int M, N, K; };

struct StaticOrder {
    int nM, nN, nwg, G, c;
    __host__ __device__ void init(int M, int N, int G_, int c_) { nM = M / BM; nN = N / BM; nwg = nM * nN; G = G_; c = c_; }
    __host__ __device__ bool next(int i, Unit& u) const {
        const long L = (long)i * G + c; if (L >= nwg) return false;
        int wgid = (int)L; { const int q = nwg / NXCD, r = nwg % NXCD, xcd = wgid % NXCD, off = wgid / NXCD; wgid = (xcd < r ? xcd * (q + 1) : r * (q + 1) + (xcd - r) * q) + off; }
        const int nig = WGM * nN, gid = wgid / nig, fm = gid * WGM, gsz = (nM - fm) < WGM ? (nM - fm) : WGM;
        u.pm = fm + ((wgid % nig) % gsz); u.pn = (wgid % nig) / gsz; return true;
    }
    __device__ __forceinline__ void a_ready(const Unit&) const {}
    __device__ __forceinline__ void done(const Unit&) const {}
};

struct EpiIn {
    static constexpr bool PERM = true, AFTER_DRAIN = false;
    bf16_t* PJ; const float* RS; float* out;
    __device__ __forceinline__ void operator()(const f32x4 (&acc)[2][2][4][2], const Unit& u, int wr, int wc, int fr, int fq) const {
        const int pn = u.pn;
        const float qs = (pn == 9 || pn == 10) ? QSCALE : 1.0f;
#pragma unroll
        for (int ai = 0; ai < 2; ++ai)
#pragma unroll
            for (int m = 0; m < 4; ++m) {
                const int row = u.pm * BM + ai * HALF + wr * 64 + m * 16 + fr;
                const float rs = RS[row];
                const float rq = rs * qs;
#pragma unroll
                for (int bj = 0; bj < 2; ++bj) {
                    const int col0 = pn * BM + bj * HALF + wc * 32 + 8 * fq;
                    const f32x4 a0 = acc[ai][bj][m][0], a1 = acc[ai][bj][m][1];
                    u32x4 w; w.x = cvtpk(a0[0] * rq, a0[1] * rq); w.y = cvtpk(a0[2] * rq, a0[3] * rq); w.z = cvtpk(a1[0] * rq, a1[1] * rq); w.w = cvtpk(a1[2] * rq, a1[3] * rq);
                    if (!(pn == 13)) *(u32x4*)(PJ + (size_t)row * NP + col0) = w;
                    if (row < MTOT) {
                        if (pn >= 13) {
                            const f32x4 v0 = a0 * rs, v1 = a1 * rs;
                            const int c = col0 - C_KV;
                            if (c < 512) { float* o = out + O_KVP + (size_t)row * 512 + c; *(f32x4*)o = v0; *(f32x4*)(o + 4) = v1; }
                            else {
                                const int cw = c - 512;
                                if (row < MP) { const int t = row & 2047, b = row >> 11; if (t >= 1536) { float* o = out + O_WINP + ((size_t)b * 512 + (t - 1536)) * 256 + cw; *(f32x4*)o = v0; *(f32x4*)(o + 4) = v1; } }
                                else { const int r2 = row - MP, t = r2 & 3, b = r2 >> 2; float* o = out + O_WINS + ((size_t)b * 512 + 508 + t) * 256 + cw; *(f32x4*)o = v0; *(f32x4*)(o + 4) = v1; }
                            }
                        } else if (pn <= 6 && col0 < ZW) {
                            if (row < MP) { if ((row & 2047) == 2047) { float* o = out + O_SHP + (size_t)(row >> 11) * ZW + col0; *(f32x4*)o = a0 * rs; *(f32x4*)(o + 4) = a1 * rs; } }
                            else { const int r2 = row - MP; if ((r2 & 3) == 3) { float* o = out + O_SHS + (size_t)(r2 >> 2) * ZW + col0; *(f32x4*)o = a0 * rs; *(f32x4*)(o + 4) = a1 * rs; } }
                        }
                    }
                }
            }
    }
};
struct EpiOut {
    static constexpr bool PERM = true, AFTER_DRAIN = false;
    const bf16_t* xb; bf16_t* yb;
    __device__ __forceinline__ void operator()(const f32x4 (&acc)[2][2][4][2], const Unit& u, int wr, int wc, int fr, int fq) const {
#pragma unroll
        for (int ai = 0; ai < 2; ++ai)
#pragma unroll
            for (int m = 0; m < 4; ++m) {
                const int row = u.pm * BM + ai * HALF + wr * 64 + m * 16 + fr;
                const bf16_t* xr = xb + (size_t)row * DM;
#pragma unroll
                for (int bj = 0; bj < 2; ++bj) {
                    const int col0 = u.pn * BM + bj * HALF + wc * 32 + 8 * fq;
                    const u32x4 xw = *(const u32x4*)(xr + col0);
                    const f32x4 x0 = (f32x4){bflo(xw.x), bfhi(xw.x), bflo(xw.y), bfhi(xw.y)} + acc[ai][bj][m][0], x1 = (f32x4){bflo(xw.z), bfhi(xw.z), bflo(xw.w), bfhi(xw.w)} + acc[ai][bj][m][1];
                    u32x4 w; w.x = cvtpk(x0[0], x0[1]); w.y = cvtpk(x0[2], x0[3]); w.z = cvtpk(x1[0], x1[1]); w.w = cvtpk(x1[2], x1[3]);
                    *(u32x4*)(yb + (size_t)row * DM + col0) = w;
                }
            }
    }
};
template <class Epi, class Sched, bool ALIGN_EPI = false, bool SP2 = false>
__device__ __forceinline__ void gemm_phase(PG8_LAS unsigned char* lds, const Gemm g, const Sched& S, const Epi& E) {
    const int tid = threadIdx.x, wid = __builtin_amdgcn_readfirstlane(tid >> 6), lane = tid & 63, wr = wid >> 2, wc = wid & 3, fr = lane & 15, fq = lane >> 4;
    const int K = g.K, nt = K / BK;
    unsigned voffA[2], voffB[2];
#pragma unroll
    for (int i = 0; i < 2; ++i) { int R, C; stage_rc(tid * 16 + i * 8192, R, C); const int Rb = Epi::PERM ? ((R & ~31) + perm32(R & 31)) : R;
        voffA[i] = (unsigned)(R * K + C) * 2u; voffB[i] = (unsigned)(Rb * K + C) * 2u; }
    const size_t kstep = (size_t)(BK * 2);
    const size_t hstep = (size_t)HALF * K * 2;
    const size_t tstep = 2 * hstep;
    const unsigned ldsw = (unsigned)wid * 1024u;
    const int aoff = lds_byte(wr * 64 + fr, fq * 8), boff = lds_byte(wc * 32 + fr, fq * 8);
#define PG8_SA(b, h) (((b) * 2 + (h)) * HTB)
#define PG8_SB(b, h) ((4 + (b) * 2 + (h)) * HTB)
#define PG8_STAGE(bufoff, gbase, voff) do { _Pragma("unroll") for (int _i = 0; _i < 2; ++_i) \
        __builtin_amdgcn_global_load_lds((const unsigned*)((const char*)(gbase) + (voff)[_i]), (PG8_LAS unsigned*)(lds + (bufoff) + ldsw + _i * 8192), 16, 0, 0); } while (0)
#define PG8_LDA(dst, b, h) do { _Pragma("unroll") for (int m = 0; m < 4; ++m) _Pragma("unroll") for (int k = 0; k < 2; ++k) dst[m][k] = *(const PG8_LAS bf16x8*)(lds + PG8_SA(b, h) + aoff + m * 2048 + k * 1024); } while (0)
#define PG8_LDB(dst, b, h) do { _Pragma("unroll") for (int n = 0; n < 2; ++n) _Pragma("unroll") for (int k = 0; k < 2; ++k) dst[n][k] = *(const PG8_LAS bf16x8*)(lds + PG8_SB(b, h) + boff + n * 2048 + k * 1024); } while (0)
#define PG8_MMA(ai, bj, At, Bt) do { __builtin_amdgcn_s_setprio(1); _Pragma("unroll") for (int m = 0; m < 4; ++m) _Pragma("unroll") for (int n = 0; n < 2; ++n) _Pragma("unroll") for (int k = 0; k < 2; ++k) \
        acc[ai][bj][m][n] = __builtin_amdgcn_mfma_f32_16x16x32_bf16(Bt[n][k], At[m][k], acc[ai][bj][m][n], 0, 0, 0); __builtin_amdgcn_s_setprio(0); } while (0)
#define PG8_WAIT_V(n) asm volatile("s_waitcnt vmcnt(" #n ")" ::: "memory")
#define PG8_WAIT_L(n) asm volatile("s_waitcnt lgkmcnt(" #n ")" ::: "memory")
#define PG8_BAR __builtin_amdgcn_s_barrier()
#define PG8_SCHED __builtin_amdgcn_sched_barrier(0)
    Unit cur, nxt; int ui = 0;
    if (!S.next(0, cur)) return;
    f32x4 acc[2][2][4][2];
#pragma unroll
    for (int a = 0; a < 2; ++a)
#pragma unroll
        for (int b = 0; b < 2; ++b)
#pragma unroll
            for (int m = 0; m < 4; ++m)
#pragma unroll
                for (int n = 0; n < 2; ++n) acc[a][b][m][n] = (f32x4){0.f, 0.f, 0.f, 0.f};
    bf16x8 At[4][2], B0[2][2], B1[2][2];
    const char* cA = (const char*)g.A + (size_t)cur.pm * tstep; const char* cB = (const char*)g.Bt + (size_t)cur.pn * tstep;
    S.a_ready(cur);
    if constexpr (SP2) {
        PG8_STAGE(PG8_SB(0, 0), cB, voffB); PG8_STAGE(PG8_SB(0, 1), cB + hstep, voffB); PG8_STAGE(PG8_SA(0, 0), cA, voffA); PG8_STAGE(PG8_SA(0, 1), cA + hstep, voffA);
        if (wr == 1) PG8_BAR;
        PG8_WAIT_V(2); PG8_BAR;
        PG8_STAGE(PG8_SB(1, 0), cB + kstep, voffB); PG8_STAGE(PG8_SA(1, 0), cA + kstep, voffA); PG8_STAGE(PG8_SB(1, 1), cB + hstep + kstep, voffB);
        PG8_WAIT_V(6); PG8_BAR;
    } else {
        PG8_STAGE(PG8_SB(0, 0), cB, voffB); PG8_STAGE(PG8_SA(0, 0), cA, voffA); PG8_STAGE(PG8_SB(0, 1), cB + hstep, voffB); PG8_STAGE(PG8_SA(0, 1), cA + hstep, voffA);
        if (wr == 1) PG8_BAR;
        PG8_WAIT_V(4); PG8_BAR;
        PG8_STAGE(PG8_SB(1, 0), cB + kstep, voffB); PG8_STAGE(PG8_SA(1, 0), cA + kstep, voffA); PG8_STAGE(PG8_SB(1, 1), cB + hstep + kstep, voffB);
        PG8_WAIT_V(6); PG8_BAR;
    }
    for (;;) {
        const bool has_next = S.next(ui + 1, nxt);
        const char* nA = has_next ? (const char*)g.A + (size_t)nxt.pm * tstep : cA; const char* nB = has_next ? (const char*)g.Bt + (size_t)nxt.pn * tstep : cB;
        for (int t = 0; t < nt; t += 2) {
            const bool last = (t == nt - 2);
            const char* a1 = cA + (size_t)(t + 1) * kstep;
            const char* a2 = last ? nA : cA + (size_t)(t + 2) * kstep; const char* b2 = last ? nB : cB + (size_t)(t + 2) * kstep;
            const char* a3 = a2 + kstep; const char* b3 = b2 + kstep;
            if (last && has_next) S.a_ready(nxt);
            if constexpr (SP2) {
            PG8_LDB(B0, 0, 0); PG8_LDB(B1, 0, 1); PG8_SCHED; PG8_LDA(At, 0, 0); PG8_STAGE(PG8_SA(1, 1), a1 + hstep, voffA);
            PG8_WAIT_V(8); PG8_WAIT_L(0); PG8_BAR; PG8_MMA(0, 0, At, B0); PG8_MMA(0, 1, At, B1); PG8_BAR; PG8_SCHED;
            PG8_LDA(At, 0, 1); PG8_STAGE(PG8_SB(0, 0), b2, voffB); PG8_STAGE(PG8_SB(0, 1), b2 + hstep, voffB); PG8_STAGE(PG8_SA(0, 0), a2, voffA);
            PG8_WAIT_V(8); PG8_WAIT_L(0); PG8_BAR; PG8_MMA(1, 0, At, B0); PG8_MMA(1, 1, At, B1); PG8_BAR; PG8_SCHED;
            PG8_LDB(B0, 1, 0); PG8_LDB(B1, 1, 1); PG8_SCHED; PG8_LDA(At, 1, 0); PG8_STAGE(PG8_SA(0, 1), a2 + hstep, voffA);
            PG8_WAIT_V(8); PG8_WAIT_L(0); PG8_BAR; PG8_MMA(0, 0, At, B0); PG8_MMA(0, 1, At, B1); PG8_BAR; PG8_SCHED;
            PG8_LDA(At, 1, 1); PG8_STAGE(PG8_SB(1, 0), b3, voffB); PG8_STAGE(PG8_SB(1, 1), b3 + hstep, voffB); PG8_STAGE(PG8_SA(1, 0), a3, voffA);
            PG8_WAIT_V(8); PG8_WAIT_L(0); PG8_BAR; PG8_MMA(1, 0, At, B0); PG8_MMA(1, 1, At, B1); PG8_BAR; PG8_SCHED;
            } else {
            PG8_LDB(B0, 0, 0); PG8_SCHED; PG8_LDA(At, 0, 0); PG8_STAGE(PG8_SA(1, 1), a1 + hstep, voffA);
            PG8_WAIT_L(8); PG8_BAR; PG8_WAIT_L(0); PG8_MMA(0, 0, At, B0); PG8_BAR; PG8_SCHED;
            PG8_LDB(B1, 0, 1); PG8_STAGE(PG8_SB(0, 0), b2, voffB);
            PG8_BAR; PG8_WAIT_L(0); PG8_MMA(0, 1, At, B1); PG8_BAR;
            PG8_LDA(At, 0, 1); PG8_STAGE(PG8_SA(0, 0), a2, voffA);
            PG8_BAR; PG8_WAIT_L(0); PG8_MMA(1, 0, At, B0); PG8_BAR; PG8_SCHED;
            PG8_STAGE(PG8_SB(0, 1), b2 + hstep, voffB);
            PG8_WAIT_V(6); PG8_BAR; PG8_MMA(1, 1, At, B1); PG8_BAR;
            PG8_LDB(B0, 1, 0); PG8_SCHED; PG8_LDA(At, 1, 0); PG8_STAGE(PG8_SA(0, 1), a2 + hstep, voffA);
            PG8_WAIT_L(8); PG8_BAR; PG8_WAIT_L(0); PG8_MMA(0, 0, At, B0); PG8_BAR; PG8_SCHED;
            PG8_LDB(B1, 1, 1); PG8_STAGE(PG8_SB(1, 0), b3, voffB);
            PG8_BAR; PG8_WAIT_L(0); PG8_MMA(0, 1, At, B1); PG8_BAR;
            PG8_LDA(At, 1, 1); PG8_STAGE(PG8_SA(1, 0), a3, voffA);
            PG8_BAR; PG8_WAIT_L(0); PG8_MMA(1, 0, At, B0); PG8_BAR; PG8_SCHED;
            PG8_STAGE(PG8_SB(1, 1), b3 + hstep, voffB);
            PG8_WAIT_V(6); PG8_BAR; PG8_MMA(1, 1, At, B1); PG8_BAR;
            }
        }
        if constexpr (ALIGN_EPI) { if (wr == 0) PG8_BAR; }
        if constexpr (!Epi::AFTER_DRAIN) { E(acc, cur, wr, wc, fr, fq); S.done(cur); }
        if (!has_next) break;
#pragma unroll
        for (int a = 0; a < 2; ++a)
#pragma unroll
            for (int b = 0; b < 2; ++b)
#pragma unroll
                for (int m = 0; m < 4; ++m)
#pragma unroll
                    for (int n = 0; n < 2; ++n) acc[a][b][m][n] = (f32x4){0.f, 0.f, 0.f, 0.f};
        cur = nxt; cA = nA; cB = nB; ++ui;
        if constexpr (ALIGN_EPI) { if (wr == 1) PG8_BAR; }
    }
    PG8_WAIT_V(0);
    if constexpr (!ALIGN_EPI) { if (wr == 0) PG8_BAR; }
    PG8_BAR;
    if constexpr (Epi::AFTER_DRAIN) { E.fused(acc, cur, wr, wc, fr, fq, lds, wid, lane); S.done(cur); }
#undef PG8_SA
#undef PG8_SB
#undef PG8_STAGE
#undef PG8_LDA
#undef PG8_LDB
#undef PG8_MMA
#undef PG8_WAIT_V
#undef PG8_WAIT_L
#undef PG8_BAR
#undef PG8_SCHED
}
}

template <class F>
__device__ __forceinline__ void sample_gemm(const unsigned short* A, const unsigned short* Bt, int ncb, int first, int stride, int wid, int lane, __attribute__((address_space(3))) unsigned char* lds, const F& fn) {
    typedef short bf16x8_t __attribute__((ext_vector_type(8)));
    typedef float f32x16_t __attribute__((ext_vector_type(16)));
    typedef float f32x4_t __attribute__((ext_vector_type(4)));
    const int r32 = lane & 31, hi = lane >> 5, rt = wid & 3, kh = wid >> 2;
    for (int cb = first; cb < ncb; cb += stride) {
        f32x16_t acc = (f32x16_t){};
        const unsigned short* ap = A + (size_t)(32 * rt + r32) * 1024 + 512 * kh + 8 * hi;
        const unsigned short* bp = Bt + (size_t)(cb * 32 + r32) * 1024 + 512 * kh + 8 * hi;
#pragma unroll 16
        for (int ks = 0; ks < 32; ++ks) acc = __builtin_amdgcn_mfma_f32_32x32x16_bf16(*(const bf16x8_t*)(ap + 16 * ks), *(const bf16x8_t*)(bp + 16 * ks), acc, 0, 0, 0);
        __attribute__((address_space(3))) f32x4_t* ex = (__attribute__((address_space(3))) f32x4_t*)lds + (rt * 64 + lane) * 4;
        __syncthreads();
        if (kh == 1) {
#pragma unroll
            for (int q = 0; q < 4; ++q) ex[q] = (f32x4_t){acc[4 * q], acc[4 * q + 1], acc[4 * q + 2], acc[4 * q + 3]};
        }
        __syncthreads();
        if (kh == 0) {
#pragma unroll
            for (int q = 0; q < 4; ++q) { const f32x4_t o = ex[q]; acc[4 * q] += o.x; acc[4 * q + 1] += o.y; acc[4 * q + 2] += o.z; acc[4 * q + 3] += o.w; }
#pragma unroll
            for (int r = 0; r < 16; ++r) fn(32 * rt + (r & 3) + 8 * (r >> 2) + 4 * hi, cb * 32 + r32, acc[r]);
        }
    }
    __syncthreads();
}

#define XB_TMO      128
#define XB_XCNT(j)  (256  + 64 * (j))
#define XB_XSUB(j)  (1280 + 64 * (j))
#define XB_XGEN(j)  (2304 + 64 * (j))
#define XB_TOP      3328
#define XB_TOPGEN   3392
#define XCD_BAR_WORDS 3456
#define XB_SPIN_CAP (1u << 18)

__device__ __forceinline__ unsigned xb_ld(unsigned* p)              { return __hip_atomic_load(p, __ATOMIC_RELAXED, __HIP_MEMORY_SCOPE_AGENT); }
__device__ __forceinline__ unsigned xb_add(unsigned* p, unsigned v) { return __hip_atomic_fetch_add(p, v, __ATOMIC_RELAXED, __HIP_MEMORY_SCOPE_AGENT); }
__device__ __forceinline__ unsigned xb_xcc_id() { return (unsigned)__builtin_amdgcn_s_getreg((3 << 11) | 20) & 0xFu; }
#define XB_SPIN(cond, bar) do { unsigned _sp = 0; while (cond) { __builtin_amdgcn_s_sleep(1); \
    if ((++_sp & 255u) == 0u) { if (xb_ld(&(bar)[XB_TMO])) break; if (_sp > XB_SPIN_CAP) { atomicAdd(&(bar)[XB_TMO], 1u); break; } } } } while (0)

struct XcdBarrier {
    unsigned* bar; unsigned x;
    volatile LAS unsigned* st;
};

__device__ __forceinline__ XcdBarrier xcd_barrier_post(unsigned* bar, volatile LAS unsigned* st) {
    XcdBarrier b; b.bar = bar; b.x = xb_xcc_id(); b.st = st;
    if (threadIdx.x == 0) (void)xb_add(&bar[XB_XCNT(b.x)], 1u);
    return b;
}
__device__ __forceinline__ void xcd_barrier_complete(unsigned* bar, unsigned x, unsigned& nloc, unsigned& nx) {
    const unsigned G = gridDim.x * gridDim.y * gridDim.z;
    unsigned sum, cnt, mine, sp = 0u;
    for (;;) {
        sum = 0u; cnt = 0u; mine = 0u;
#pragma unroll
        for (unsigned j = 0; j < 16; ++j) { const unsigned c = xb_ld(&bar[XB_XCNT(j)]); sum += c; cnt += (c > 0u) ? 1u : 0u; mine = (j == x) ? c : mine; }
        if (sum == G) break;
        __builtin_amdgcn_s_sleep(1);
        if ((++sp & 255u) == 0u) { if (xb_ld(&bar[XB_TMO])) break; if (sp > XB_SPIN_CAP) { atomicAdd(&bar[XB_TMO], 1u); break; } }
    }
    nloc = mine > 0u ? mine : 1u; nx = cnt > 0u ? cnt : 1u;
}

__device__ __forceinline__ void xcd_barrier(const XcdBarrier& b) {
    asm volatile("s_waitcnt vmcnt(0)" ::: "memory");
    __syncthreads();
    if (threadIdx.x == 0) {
        unsigned* bar = b.bar;
        __builtin_amdgcn_s_waitcnt(0);
        unsigned nloc = b.st[0], nx = b.st[1];
        if (nloc == 0u) { xcd_barrier_complete(bar, b.x, nloc, nx); b.st[0] = nloc; b.st[1] = nx; }
        const unsigned old = xb_add(&bar[XB_XSUB(b.x)], 1u);
        const unsigned gen = old / nloc;
        if (old + 1u == (gen + 1u) * nloc) {
            __builtin_amdgcn_fence(__ATOMIC_RELEASE, "agent");
            asm volatile("s_waitcnt vmcnt(0)" ::: "memory");
            const unsigned og = xb_add(&bar[XB_TOP], 1u);
            const unsigned tg = og / nx;
            if (og + 1u == (tg + 1u) * nx) xb_add(&bar[XB_TOPGEN], 1u);
            else XB_SPIN(xb_ld(&bar[XB_TOPGEN]) == tg, bar);
            __builtin_amdgcn_fence(__ATOMIC_ACQUIRE, "agent");
            xb_add(&bar[XB_XGEN(b.x)], 1u);
            asm volatile("s_waitcnt vmcnt(0)" ::: "memory");
        } else {
            XB_SPIN(xb_ld(&bar[XB_XGEN(b.x)]) == gen, bar);
            __builtin_amdgcn_fence(__ATOMIC_ACQUIRE, "agent");
            asm volatile("s_waitcnt vmcnt(0)" ::: "memory");
        }
    }
    __syncthreads();
}

struct Ctx {
    const float *xp, *xs, *cache, *win, *swkv, *sshift; const int* pt;
    const float *norm_g, *w_in, *mu, *w0, *wdu, *a0, *wau, *k_k, *k_a, *r_k, *gn_w, *gn_b, *wpos, *wmix, *w_out, *final_g;
    float* out; unsigned char* ws;
    bf16_t *WinT, *WoutT, *XB, *MIX, *PJ, *CMPK_P, *CMPV_P, *CMPK_S, *CMPV_S, *WduT, *WauT;
    unsigned char* CHK; unsigned char* S0R;
    float *RS, *BONUS, *RWkk, *RWw, *RWb, *RWk, *RWr, *RWv;
    int tid, lane, wid, bid, G, gw, NGW;
};

__device__ __forceinline__ int orig_col(int n) {
    if (n < 1664) return n;
    if (n < 1688) return 3968 + (n - 1664);
    if (n < 1792) return -1;
    if (n < 2304) return 1664 + (n - 1792);
    if (n < 2816) return 2176 + (n - 2304);
    if (n < 3328) return 2688 + (n - 2816);
    return 3200 + (n - 3328);
}
__device__ __forceinline__ void transpose_item(const float* W, int ldw, const float* gscale, bool permute, bf16_t* WT, int K, LAS float* scr, int item, int nblk, int lane) {
    const int kb = item / nblk, nb = item % nblk, k0 = 64 * kb, n0 = 32 * nb;
    const int n = n0 + (lane & 31); const int oc = permute ? orig_col(n) : n;
#pragma unroll 8
    for (int i = 0; i < 32; ++i) {
        const int kk = 2 * i + (lane >> 5); float v = 0.f;
        if (oc >= 0) { v = W[(size_t)(k0 + kk) * ldw + oc]; if (gscale) v *= gscale[k0 + kk]; }
        scr[kk * 33 + (lane & 31)] = v;
    }
    asm volatile("s_waitcnt lgkmcnt(0)" ::: "memory");
    const int c = lane & 7;
#pragma unroll
    for (int j = 0; j < 4; ++j) {
        const int nn = (lane >> 3) + 8 * j; const LAS float* s = scr + (8 * c) * 33 + nn;
        u32x4 o; o.x = cvtpk(s[0 * 33], s[1 * 33]); o.y = cvtpk(s[2 * 33], s[3 * 33]); o.z = cvtpk(s[4 * 33], s[5 * 33]); o.w = cvtpk(s[6 * 33], s[7 * 33]);
        *(u32x4*)(WT + (size_t)(n0 + nn) * K + k0 + 8 * c) = o;
    }
    asm volatile("s_waitcnt lgkmcnt(0)" ::: "memory");
}

struct RowsPrompt { const float* kvp; __device__ __forceinline__ const float* operator()(int b, int pos) const { return kvp + ((size_t)(b * 2048 + pos)) * 512; } };
struct RowsSample { const float* cache; const int* pt; __device__ __forceinline__ const float* operator()(int b, int pos) const { const int pg = pt[b * 128 + (pos >> 7)]; return cache + ((size_t)pg * 128 + (pos & 127)) * 512; } };

constexpr int CMP_WP = 0, CMP_WT = 16384, CMP_X = 34816, CMP_PA = 53248, CMP_PB = 87040, CMP_END = 120832, CMP_LD = 72;
__device__ __forceinline__ void load_cmp_consts(const Ctx& C, LAS unsigned char* lds) {
    LAS float* wp = (LAS float*)(lds + CMP_WP); LAS bf16_t* wt = (LAS bf16_t*)(lds + CMP_WT);
    for (int i = C.tid; i < 2 * 32 * 64; i += 512) wp[i] = C.wpos[i];
    for (int i = C.tid; i < 2 * 64 * 64; i += 512) { const int e = i >> 12, d = (i >> 6) & 63, f = i & 63; wt[(e * 64 + f) * CMP_LD + d] = f2bf(C.wmix[i]); }
    LDS_BAR();
}
struct CmpW { f32x4 w1[16], w2[16]; };
__device__ __forceinline__ void load_cmp_w(const Ctx& C, CmpW& W) {
    const int e4 = C.lane >> 5, d0 = (4 * C.lane) & 63;
#pragma unroll
    for (int p = 0; p < 16; ++p) { W.w1[p] = *(const f32x4*)(C.wpos + (e4 * 32 + p) * 64 + d0); W.w2[p] = *(const f32x4*)(C.wpos + (e4 * 32 + 16 + p) * 64 + d0); }
}
template <class Rows>
__device__ __forceinline__ void compress_item(const Rows& R, int b, int j0, int nj, LAS unsigned char* lds, bf16_t* outK, bf16_t* outV, int jpitch, int tid, int lane, int wid, const CmpW& W) {
    LAS float* PA = (LAS float*)(lds + CMP_PA); LAS float* PB = (LAS float*)(lds + CMP_PB);
    for (int cl = wid; cl <= nj; cl += 8) {
        const float* base = R(b, 16 * (j0 + cl)) + 4 * lane;
        f32x4 v[16];
#pragma unroll
        for (int p = 0; p < 16; ++p) v[p] = __builtin_nontemporal_load((const f32x4*)(base + (size_t)p * 512));
        f32x4 a = (f32x4){0.f, 0.f, 0.f, 0.f}, bb = a;
#pragma unroll
        for (int p = 0; p < 16; ++p) { a += v[p] * W.w1[p]; bb += v[p] * W.w2[p]; }
        *(LAS f32x4*)(PA + cl * 256 + 4 * lane) = a; *(LAS f32x4*)(PB + cl * 256 + 4 * lane) = bb;
    }
    LDS_BAR();
    {
        LAS bf16_t* X = (LAS bf16_t*)(lds + CMP_X);
#pragma unroll
        for (int k = 0; k < 4; ++k) {
            const int i = tid + 512 * k, jj = i >> 6, c4 = i & 63, col = 4 * c4, e = col >> 7, kvh = (col >> 6) & 1, d = col & 63;
            f32x4 p = (f32x4){0.f, 0.f, 0.f, 0.f};
            if (jj < nj) p = *(const LAS f32x4*)(PA + jj * 256 + col) + *(const LAS f32x4*)(PB + (jj + 1) * 256 + col);
            u32x2 w; w.x = cvtpk(p.x, p.y); w.y = cvtpk(p.z, p.w);
            *(LAS u32x2*)(X + (e * 64 + 2 * jj + kvh) * CMP_LD + d) = w;
        }
    }
    LDS_BAR();
    {
        const int r32 = lane & 31, hi = lane >> 5, e = wid >> 2, tm = (wid >> 1) & 1, tn = wid & 1;
        const LAS char* A = (const LAS char*)(lds + CMP_X) + e * 64 * CMP_LD * 2; const LAS char* Bt = (const LAS char*)(lds + CMP_WT) + e * 64 * CMP_LD * 2;
        f32x16 acc = (f32x16){};
#pragma unroll
        for (int ks = 0; ks < 4; ++ks) {
            const bf16x8 af = *(const LAS bf16x8*)(A + ((32 * tm + r32) * CMP_LD + 16 * ks + 8 * hi) * 2), bf = *(const LAS bf16x8*)(Bt + ((32 * tn + r32) * CMP_LD + 16 * ks + 8 * hi) * 2);
            acc = __builtin_amdgcn_mfma_f32_32x32x16_bf16(af, bf, acc, 0, 0, 0);
        }
        bf16_t* ob = (e == 0 ? outK : outV);
#pragma unroll
        for (int r = 0; r < 16; ++r) {
            const int row = 32 * tm + (r & 3) + 8 * (r >> 2) + 4 * hi, jj = row >> 1, kvh = row & 1;
            if (jj < nj) ob[((size_t)(b * 2 + kvh) * jpitch + j0 + jj) * 64 + 32 * tn + r32] = f2bf(acc[r]);
        }
    }
    LDS_BAR();
}

__device__ __forceinline__ void p0_prologue(const Ctx& C, LAS unsigned char* lds) {
    {
        LAS float* scr = (LAS float*)(lds + C.wid * 16384);
        constexpr int I_IN = (DM / 64) * (NP / 32), I_OUT = (DM / 64) * (DM / 32);
        for (int it = C.gw; it < I_IN + I_OUT; it += C.NGW) {
            if (it < I_IN) transpose_item(C.w_in, NPROJ, C.norm_g, true, C.WinT, DM, scr, it, NP / 32, C.lane);
            else transpose_item(C.w_out, DM, nullptr, false, C.WoutT, DM, scr, it - I_IN, DM / 32, C.lane);
        }
    }
    for (int i = C.bid * 512 + C.tid; i < 2 * 512 * 64; i += C.G * 512) {
        const int which = i >> 15, r = i & 32767, n = r >> 6, c = r & 63;
        const float v = (which ? C.wau : C.wdu)[c * 512 + n];
        (which ? C.WauT : C.WduT)[n * 64 + c] = f2bf(v);
    }
    for (int m4 = C.gw * 4; m4 < MTOT; m4 += C.NGW * 4) {
        f32x4 v[4][4]; float ss[4];
#pragma unroll
        for (int q = 0; q < 4; ++q) {
            const int m = m4 + q;
            const float* xr = m < MP ? C.xp + (size_t)m * DM : C.xs + (size_t)(m - MP) * DM;
#pragma unroll
            for (int j = 0; j < 4; ++j) v[q][j] = *(const f32x4*)(xr + 4 * (C.lane + 64 * j));
        }
#pragma unroll
        for (int q = 0; q < 4; ++q) {
            float a = 0.f;
#pragma unroll
            for (int j = 0; j < 4; ++j) a += (v[q][j].x * v[q][j].x + v[q][j].y * v[q][j].y) + (v[q][j].z * v[q][j].z + v[q][j].w * v[q][j].w);
            ss[q] = wave_sum_dpp(a);
        }
#pragma unroll
        for (int q = 0; q < 4; ++q) {
            const int m = m4 + q;
            if (C.lane == 0) C.RS[m] = 1.0f / sqrtf(ss[q] * (1.0f / DM) + 1e-6f);
#pragma unroll
            for (int j = 0; j < 4; ++j) { u32x2 o; o.x = cvtpk(v[q][j].x, v[q][j].y); o.y = cvtpk(v[q][j].z, v[q][j].w); *(u32x2*)(C.XB + (size_t)m * DM + 4 * (C.lane + 64 * j)) = o; }
        }
    }
    for (int i = C.bid * 512 + C.tid; i < DECB * 508 * 64; i += C.G * 512) {
        const int b = i / (508 * 64), rem = i % (508 * 64), r = rem >> 6, c4 = rem & 63;
        *(f32x4*)(C.out + O_WINS + ((size_t)b * 512 + r) * 256 + c4 * 4) = *(const f32x4*)(C.win + ((size_t)b * 512 + r + 4) * 256 + c4 * 4);
    }
}

__device__ __forceinline__ float zshift(const Ctx& C, int m, int col) {
    const float z = bf2f(C.PJ[(size_t)m * NP + col]);
    float zp;
    if (m < MP) { zp = (m & 2047) ? bf2f(C.PJ[(size_t)(m - 1) * NP + col]) : 0.f; }
    else { const int r = m - MP; zp = (r & 3) ? bf2f(C.PJ[(size_t)(m - 1) * NP + col]) : C.sshift[(size_t)(r >> 2) * ZW + col]; }
    return z + (zp - z) * C.mu[col];
}
__device__ __forceinline__ void p2_compress_prompt(const Ctx& C, LAS unsigned char* lds, int first, int stride) {
    __syncthreads();
    load_cmp_consts(C, lds);
    CmpW W; load_cmp_w(C, W);
    RowsPrompt R{C.out + O_KVP};
    for (int it = first; it < BATCH * 16; it += stride) {
        const int b = it >> 4, j0 = (it & 15) * 8; const int nj = (127 - j0) < 8 ? (127 - j0) : 8;
        compress_item(R, b, j0, nj, lds, C.CMPK_P, C.CMPV_P, 128, C.tid, C.lane, C.wid, W);
    }
    __builtin_amdgcn_s_waitcnt(0x0F70);
    for (int i = first * 512 + C.tid; i < BATCH * 2 * 64; i += stride * 512) { const int bk = i >> 6, d = i & 63; C.CMPK_P[((size_t)bk * 128 + 127) * 64 + d] = 0; C.CMPV_P[((size_t)bk * 128 + 127) * 64 + d] = 0; }
    __syncthreads();
}

__device__ __forceinline__ void rwkv_sample_unit(const Ctx& C, int b, int h, LAS float* sl  ) {
    const int lane = C.lane, n = h * 64 + lane, msb = MP + b * DECT;
    LAS float* zs = sl + 320;
    LAS float* lo = sl + 1600;
    {
        const int cols[5] = {C_R + n, C_K + n, C_V + n, C_WD + lane, C_AD + lane};
#pragma unroll
        for (int sg = 0; sg < 5; ++sg) {
            const float mu = C.mu[cols[sg]];
            float prev = C.sshift[(size_t)b * ZW + cols[sg]];
#pragma unroll
            for (int t = 0; t < 4; ++t) {
                const float z = bf2f(C.PJ[(size_t)(msb + t) * NP + cols[sg]]);
                const float v = z + (prev - z) * mu;
                zs[(t * 5 + sg) * 64 + lane] = (sg == 3) ? tanhf(v) : v;
                prev = z;
            }
        }
    }
    asm volatile("s_waitcnt lgkmcnt(0)" ::: "memory");
    {
        float wl[4], al[4];
        const float w0v = C.w0[n], a0v = C.a0[n];
#pragma unroll
        for (int t = 0; t < 4; ++t) { wl[t] = w0v; al[t] = a0v; }
#pragma unroll 4
        for (int c = 0; c < 64; ++c) {
            const float wu = C.wdu[c * 512 + n], au = C.wau[c * 512 + n];
#pragma unroll
            for (int t = 0; t < 4; ++t) { wl[t] += zs[(t * 5 + 3) * 64 + c] * wu; al[t] += zs[(t * 5 + 4) * 64 + c] * au; }
        }
#pragma unroll
        for (int t = 0; t < 4; ++t) { lo[t * 128 + lane] = wl[t]; lo[t * 128 + 64 + lane] = al[t]; }
    }
    asm volatile("s_waitcnt lgkmcnt(0)" ::: "memory");
    float S[64];
    {
        const float* sp = C.swkv + ((size_t)(b * 8 + h) * 64 + lane) * 64;
#pragma unroll
        for (int j = 0; j < 64; j += 4) { const f32x4 q = *(const f32x4*)(sp + j); S[j] = q.x; S[j + 1] = q.y; S[j + 2] = q.z; S[j + 3] = q.w; }
    }
    const float gw_ = C.gn_w[n], gb_ = C.gn_b[n], kkn = C.k_k[n], kan = C.k_a[n], rkn = C.r_k[n];
#pragma unroll 1
    for (int t = 0; t < 4; ++t) {
        const int m = msb + t;
        const float r = zs[(t * 5 + 0) * 64 + lane], k = zs[(t * 5 + 1) * 64 + lane], vi = zs[(t * 5 + 2) * 64 + lane];
        const float x = -lo[t * 128 + lane];
        const float sp_ = fmaxf(x, 0.f) + log1pf(expf(-fabsf(x)));
        const float dec = expf(-expf(-sp_ - 0.5f));
        const float a = sigm(lo[t * 128 + 64 + lane]);
        float kk = k * kkn;
        const float ss = wave_sum(kk * kk);
        kk *= 1.0f / sqrtf(fmaxf(ss, 1e-24f));
        const float km = k * (1.0f + (a - 1.0f) * kan);
        const float bon = wave_sum(r * km * rkn);
        sl[0 * 64 + lane] = kk; sl[1 * 64 + lane] = dec; sl[2 * 64 + lane] = kk * a; sl[3 * 64 + lane] = km; sl[4 * 64 + lane] = r;
        asm volatile("s_waitcnt lgkmcnt(0)" ::: "memory");
        const LAS f32x4* pk = (const LAS f32x4*)(sl); const LAS f32x4* pw = (const LAS f32x4*)(sl + 64); const LAS f32x4* pb = (const LAS f32x4*)(sl + 128);
        const LAS f32x4* pm = (const LAS f32x4*)(sl + 192); const LAS f32x4* pr = (const LAS f32x4*)(sl + 256);
        float sa0 = 0.f, sa1 = 0.f;
#pragma unroll
        for (int j4 = 0; j4 < 16; ++j4) { const f32x4 q = pk[j4]; sa0 += S[4 * j4] * q.x + S[4 * j4 + 2] * q.z; sa1 += S[4 * j4 + 1] * q.y + S[4 * j4 + 3] * q.w; if ((j4 & 3) == 3) asm volatile("" ::: "memory"); }
        const float sa = sa0 + sa1;
        float y0 = 0.f, y1 = 0.f;
#pragma unroll
        for (int j4 = 0; j4 < 16; ++j4) {
            const f32x4 w4 = pw[j4], b4 = pb[j4], k4 = pm[j4], r4 = pr[j4];
            S[4 * j4 + 0] = S[4 * j4 + 0] * w4.x + (vi * k4.x - sa * b4.x); y0 += S[4 * j4 + 0] * r4.x;
            S[4 * j4 + 1] = S[4 * j4 + 1] * w4.y + (vi * k4.y - sa * b4.y); y1 += S[4 * j4 + 1] * r4.y;
            S[4 * j4 + 2] = S[4 * j4 + 2] * w4.z + (vi * k4.z - sa * b4.z); y0 += S[4 * j4 + 2] * r4.z;
            S[4 * j4 + 3] = S[4 * j4 + 3] * w4.w + (vi * k4.w - sa * b4.w); y1 += S[4 * j4 + 3] * r4.w;
            if ((j4 & 1) == 1) asm volatile("" ::: "memory");
        }
        const float y = y0 + y1;
        const float mean = wave_sum(y) * (1.0f / 64.0f); const float yc = y - mean;
        const float var = wave_sum(yc * yc) * (1.0f / 64.0f);
        float yn = yc * (1.0f / sqrtf(var + 64e-5f)) * gw_ + gb_;
        yn += bon * vi;
        const float gate = bf2f(C.PJ[(size_t)m * NP + C_GR + n]);
        C.MIX[(size_t)m * DM + n] = f2bf(yn * silu(gate));
        asm volatile("s_waitcnt lgkmcnt(0)" ::: "memory");
    }
    float* so = C.out + O_WKVS + ((size_t)(b * 8 + h) * 64 + lane) * 64;
#pragma unroll
    for (int j = 0; j < 64; j += 4) *(f32x4*)(so + j) = (f32x4){S[j], S[j + 1], S[j + 2], S[j + 3]};
}

namespace rk {
constexpr int LDB = 72, SLOT = 64 * LDB * 2, LDW = 68;
constexpr int OFF_WL = 8 * SLOT, OFF_AL = OFF_WL + 64 * LDW * 4, OFF_QT = 15 * SLOT, OFF_GL = OFF_QT + 8 * 64 * 4, OFF_END = OFF_GL + 256;
static_assert(OFF_AL + 64 * LDW * 4 <= 12 * SLOT && OFF_END <= MISC_OFF, "rk LDS map");
__device__ __forceinline__ int crow(int r, int hi) { return (r & 3) + 8 * (r >> 2) + 4 * hi; }
__device__ __forceinline__ LAS char* SL(LAS char* lds, int k) { return lds + k * SLOT; }
__device__ __forceinline__ bf16x8 frag(const LAS char* base, int blk, int ks, int r32, int hi) { return *(const LAS bf16x8*)(base + ((32 * blk + r32) * LDB + 16 * ks + 8 * hi) * 2); }
__device__ __forceinline__ void mm_tile(f32x16& acc, const LAS char* A, const LAS char* Bt, int tm, int tn, int r32, int hi) {
    bf16x8 fa[4], fb[4];
#pragma unroll
    for (int ks = 0; ks < 4; ++ks) { fa[ks] = frag(A, tm, ks, r32, hi); fb[ks] = frag(Bt, tn, ks, r32, hi); }
    __builtin_amdgcn_sched_barrier(0);
#pragma unroll
    for (int ks = 0; ks < 4; ++ks) acc = __builtin_amdgcn_mfma_f32_32x32x16_bf16(fa[ks], fb[ks], acc, 0, 0, 0);
}
__device__ __forceinline__ void store_T(LAS char* X, const f32x16& acc, int tm, int tn, int r32, int hi) {
#pragma unroll
    for (int g4 = 0; g4 < 4; ++g4) { u32x2 w; w.x = cvtpk(acc[4 * g4], acc[4 * g4 + 1]); w.y = cvtpk(acc[4 * g4 + 2], acc[4 * g4 + 3]); *(LAS u32x2*)(X + ((32 * tn + r32) * LDB + 32 * tm + 8 * g4 + 4 * hi) * 2) = w; }
}
__device__ __forceinline__ void store_R(LAS char* X, const f32x16& acc, int tm, int tn, int r32, int hi) {
#pragma unroll
    for (int r = 0; r < 16; ++r) *(LAS bf16_t*)(X + ((32 * tm + crow(r, hi)) * LDB + 32 * tn + r32) * 2) = f2bf(acc[r]);
}
__device__ __forceinline__ void unpack16(f32x16& a, const u32x4 lo, const u32x4 hi4) {
    a[0] = bflo(lo.x); a[1] = bfhi(lo.x); a[2] = bflo(lo.y); a[3] = bfhi(lo.y); a[4] = bflo(lo.z); a[5] = bfhi(lo.z); a[6] = bflo(lo.w); a[7] = bfhi(lo.w);
    a[8] = bflo(hi4.x); a[9] = bfhi(hi4.x); a[10] = bflo(hi4.y); a[11] = bfhi(hi4.y); a[12] = bflo(hi4.z); a[13] = bfhi(hi4.z); a[14] = bflo(hi4.w); a[15] = bfhi(hi4.w);
}
__device__ __forceinline__ u32x4 pack8(const f32x16& a, int s) { return (u32x4){cvtpk(a[8 * s], a[8 * s + 1]), cvtpk(a[8 * s + 2], a[8 * s + 3]), cvtpk(a[8 * s + 4], a[8 * s + 5]), cvtpk(a[8 * s + 6], a[8 * s + 7])}; }
constexpr int REC_GB = 0, REC_RB = 8192, REC_HB = 16384, REC_YB = 24576;

__device__ __forceinline__ void phaseA_loadWA(const Ctx& C, int b, int c, u32x4 (&z)[3]) {
    const int m0 = b * SEQ + c * 64;
#pragma unroll
    for (int k = 0; k < 3; ++k) {
        const int i = C.tid + 512 * k; const bool in = i < 65 * 16;
        const int rr = in ? i / 16 : 0, q = i % 16; const int col = ((q >> 3) ? C_AD : C_WD) + (q & 7) * 8;
        const bool has = in && (rr > 0 || c > 0);
        u32x4 v = *(const u32x4*)(C.PJ + (size_t)(m0 + rr - ((rr > 0 || c > 0) ? 1 : 0)) * NP + col);
        if (!has) v = (u32x4){0u, 0u, 0u, 0u};
        z[k] = v;
    }
}
__device__ __forceinline__ void phaseA_loadRKV(const Ctx& C, int b, int h, int c, u32x4 (&z)[4]) {
    const int m0 = b * SEQ + c * 64;
#pragma unroll
    for (int k = 0; k < 4; ++k) {
        const int i = C.tid + 512 * k; const bool in = i < 65 * 24;
        const int rr = in ? i / 24 : 0, q = i % 24; const int col = (q >> 3) * 512 + h * 64 + (q & 7) * 8;
        const bool has = in && (rr > 0 || c > 0);
        u32x4 v = *(const u32x4*)(C.PJ + (size_t)(m0 + rr - ((rr > 0 || c > 0) ? 1 : 0)) * NP + col);
        if (!has) v = (u32x4){0u, 0u, 0u, 0u};
        z[k] = v;
    }
}
struct ChanConst { float w0, a0, kk, ka, rk, mur, muk, muv, muw, mua; };
__device__ __forceinline__ void phaseA_item(const Ctx& C, LAS char* lds, int b, int h, int c, u32x4 (&zwa)[3], bool has_next, int nb, int nc, const ChanConst& cc) {
    const int tid = C.tid, lane = C.lane, wid = C.wid, r32 = lane & 31, hi = lane >> 5;
    const int gr = wid >> 2, w4 = wid & 3, tm = w4 >> 1, tn = w4 & 1;
    const int m0 = b * SEQ + c * 64;
    const int n = h * 64 + lane;
    unsigned char* rec = C.CHK + (size_t)((b * 8 + h) * 32 + c) * CHK_BYTES;
    LAS float* QT = (LAS float*)(lds + OFF_QT); LAS float* GL = (LAS float*)(lds + OFF_GL);
    LDS_BAR();
    bf16x8 wfr[4];
    {
        const bf16_t* WT = (gr == 0 ? C.WduT : C.WauT) + (size_t)(h * 64 + 32 * tn + r32) * 64 + 8 * hi;
#pragma unroll
        for (int ks = 0; ks < 4; ++ks) wfr[ks] = *(const bf16x8*)(WT + 16 * ks);
    }
    u32x4 zrkv[4];
    {
        LAS char* Z = SL(lds, 0);
#pragma unroll
        for (int k = 0; k < 3; ++k) { const int i = tid + 512 * k; if (i < 65 * 16) { const int rr = i / 16, q = i % 16; *(LAS u32x4*)(Z + (rr * 5 + 3 + (q >> 3)) * 128 + (q & 7) * 16) = zwa[k]; } }
        phaseA_loadRKV(C, b, h, c, zrkv);
    }
    LDS_BAR();
    const LAS bf16_t* Zb = (const LAS bf16_t*)SL(lds, 0);
#define ZSH(t, seg, mu_) ({ const float z_ = bf2f(Zb[(((t) + 1) * 5 + (seg)) * 64 + lane]), zp_ = bf2f(Zb[((t) * 5 + (seg)) * 64 + lane]); z_ + (zp_ - z_) * (mu_); })
    {
        LAS bf16_t* TW = (LAS bf16_t*)SL(lds, 13); LAS bf16_t* AD = (LAS bf16_t*)SL(lds, 14);
        const float muw = cc.muw, mua = cc.mua;
#pragma unroll
        for (int tk = 0; tk < 8; ++tk) {
            const int t = 8 * wid + tk;
            TW[t * LDB + lane] = f2bf(ftanh(ZSH(t, 3, muw)));
            AD[t * LDB + lane] = f2bf(ZSH(t, 4, mua));
        }
    }
    LDS_BAR();
    {
        f32x16 acc = (f32x16){};
        const LAS char* A = SL(lds, gr == 0 ? 13 : 14);
#pragma unroll
        for (int ks = 0; ks < 4; ++ks) acc = __builtin_amdgcn_mfma_f32_32x32x16_bf16(frag(A, tm, ks, r32, hi), wfr[ks], acc, 0, 0, 0);
        LAS float* X = (LAS float*)(lds + (gr == 0 ? OFF_WL : OFF_AL));
#pragma unroll
        for (int g4 = 0; g4 < 4; ++g4) *(LAS f32x4*)(X + (32 * tn + r32) * LDW + 32 * tm + 8 * g4 + 4 * hi) = (f32x4){acc[4 * g4], acc[4 * g4 + 1], acc[4 * g4 + 2], acc[4 * g4 + 3]};
    }
    {
        LAS char* Z = SL(lds, 0);
#pragma unroll
        for (int k = 0; k < 4; ++k) { const int i = tid + 512 * k; if (i < 65 * 24) { const int rr = i / 24, q = i % 24; *(LAS u32x4*)(Z + (rr * 5 + (q >> 3)) * 128 + (q & 7) * 16) = zrkv[k]; } }
    }
    LDS_BAR();
    {
        float lw[8], kkv[8], bav[8], kmv[8], rv[8], vv[8], cl[8];
        const LAS float* WLp = (const LAS float*)(lds + OFF_WL) + lane * LDW + 8 * wid; const LAS float* ALp = (const LAS float*)(lds + OFF_AL) + lane * LDW + 8 * wid;
        const f32x4 wa = *(const LAS f32x4*)WLp, wb = *(const LAS f32x4*)(WLp + 4), aa = *(const LAS f32x4*)ALp, ab = *(const LAS f32x4*)(ALp + 4);
        const float wlv[8] = {wa.x, wa.y, wa.z, wa.w, wb.x, wb.y, wb.z, wb.w}, alv[8] = {aa.x, aa.y, aa.z, aa.w, ab.x, ab.y, ab.z, ab.w};
        const float w0n = cc.w0, a0n = cc.a0, kkn = cc.kk, kan = cc.ka, rkn = cc.rk;
        const float mur = cc.mur, muk = cc.muk, muv = cc.muv;
        float csum = 0.f;
#pragma unroll
        for (int tk = 0; tk < 8; ++tk) {
            const int m = m0 + 8 * wid + tk;
            const float r = ZSH(8 * wid + tk, 0, mur), k = ZSH(8 * wid + tk, 1, muk), v = ZSH(8 * wid + tk, 2, muv);
            const float x = -(wlv[tk] + w0n);
            const float sp = fmaxf(x, 0.f) + __logf(1.f + fexp(-fabsf(x)));
            lw[tk] = -fexp(-sp - 0.5f);
            const float a = fsigm(alv[tk] + a0n);
            float kk = k * kkn;
            const float ss = wave_sum_dpp(kk * kk);
            kk *= rsqrtf(fmaxf(ss, 1e-24f));
            const float km = k * (1.0f + (a - 1.0f) * kan);
            const float bon = wave_sum_dpp(r * km * rkn);
            if (lane == 0) C.BONUS[(size_t)m * 8 + h] = bon;
            kkv[tk] = kk; bav[tk] = kk * a; kmv[tk] = km; rv[tk] = r; vv[tk] = v;
            csum += lw[tk]; cl[tk] = csum;
        }
        QT[wid * 64 + lane] = csum;
        LDS_BAR();
        float base = 0.f, total = 0.f;
#pragma unroll
        for (int q = 0; q < 8; ++q) { const float tq = QT[q * 64 + lane]; total += tq; if (q < wid) base += tq; }
        if (wid == 0) GL[lane] = fexp(total);
        LAS bf16_t* Rt = (LAS bf16_t*)SL(lds, 0); LAS bf16_t* At = (LAS bf16_t*)SL(lds, 5); LAS bf16_t* Bt = (LAS bf16_t*)SL(lds, 6); LAS bf16_t* Kt = (LAS bf16_t*)SL(lds, 7);
        float atv[8], bhv[8], khv[8];
#pragma unroll
        for (int tk = 0; tk < 8; ++tk) {
            const int t = 8 * wid + tk;
            const float cum = base + cl[tk], cprev = cum - lw[tk];
            const float g = fexp(cum), gp = fexp(cprev), gi = fexp(-cum), gl = fexp(total - cum);
            atv[tk] = kkv[tk] * gp; bhv[tk] = bav[tk] * gl; khv[tk] = kmv[tk] * gl;
            At[t * LDB + lane] = f2bf(atv[tk]); Bt[t * LDB + lane] = f2bf(bav[tk] * gi); Kt[t * LDB + lane] = f2bf(kmv[tk] * gi); Rt[t * LDB + lane] = f2bf(rv[tk] * g);
        }
        const int co = (lane * LDB + 8 * wid) * 2;
        *(LAS u32x4*)(SL(lds, 1) + co) = (u32x4){cvtpk(atv[0], atv[1]), cvtpk(atv[2], atv[3]), cvtpk(atv[4], atv[5]), cvtpk(atv[6], atv[7])};
        *(LAS u32x4*)(SL(lds, 2) + co) = (u32x4){cvtpk(vv[0], vv[1]), cvtpk(vv[2], vv[3]), cvtpk(vv[4], vv[5]), cvtpk(vv[6], vv[7])};
        *(LAS u32x4*)(SL(lds, 3) + co) = (u32x4){cvtpk(bhv[0], bhv[1]), cvtpk(bhv[2], bhv[3]), cvtpk(bhv[4], bhv[5]), cvtpk(bhv[6], bhv[7])};
        *(LAS u32x4*)(SL(lds, 4) + co) = (u32x4){cvtpk(khv[0], khv[1]), cvtpk(khv[2], khv[3]), cvtpk(khv[4], khv[5]), cvtpk(khv[6], khv[7])};
    }
    LDS_BAR();
#undef ZSH
    f32x16 Tt = (f32x16){}, hacc = (f32x16){}, yacc = (f32x16){};
    const int colg = 32 * tn + r32;
    int dm = colg - 32 * tm - 4 * hi; asm volatile("" : "+v"(dm));
#define CRW(r) (((r) & 3) + 8 * ((r) >> 2))
    if (gr == 0) {
        f32x16 acc = (f32x16){}; mm_tile(acc, SL(lds, 5), SL(lds, 6), tm, tn, r32, hi);
#pragma unroll
        for (int r = 0; r < 16; ++r) { const float y = (dm < CRW(r)) ? -acc[r] : 0.f; acc[r] = y; Tt[r] = y + ((dm == CRW(r)) ? 1.f : 0.f); }
        store_R(SL(lds, 8), acc, tm, tn, r32, hi); store_T(SL(lds, 9), acc, tm, tn, r32, hi); store_T(SL(lds, 13), Tt, tm, tn, r32, hi);
        acc = (f32x16){}; mm_tile(acc, SL(lds, 6), SL(lds, 0), tm, tn, r32, hi);
#pragma unroll
        for (int r = 0; r < 16; ++r) acc[r] = (CRW(r) <= dm) ? acc[r] : 0.f;
        store_T(SL(lds, 11), acc, tm, tn, r32, hi);
    } else {
        f32x16 acc = (f32x16){}; mm_tile(acc, SL(lds, 7), SL(lds, 5), tm, tn, r32, hi);
#pragma unroll
        for (int r = 0; r < 16; ++r) acc[r] = (CRW(r) < dm) ? acc[r] : 0.f;
        store_T(SL(lds, 10), acc, tm, tn, r32, hi);
        acc = (f32x16){}; mm_tile(acc, SL(lds, 7), SL(lds, 0), tm, tn, r32, hi);
#pragma unroll
        for (int r = 0; r < 16; ++r) acc[r] = (CRW(r) <= dm) ? acc[r] : 0.f;
        store_T(SL(lds, 12), acc, tm, tn, r32, hi);
    }
    LDS_BAR();
    if (gr == 1) { f32x16 acc = (f32x16){}; mm_tile(acc, SL(lds, 8), SL(lds, 9), tm, tn, r32, hi); store_R(SL(lds, 5), acc, tm, tn, r32, hi); store_T(SL(lds, 6), acc, tm, tn, r32, hi); }
    else { f32x16 acc = (f32x16){}; mm_tile(acc, SL(lds, 10), SL(lds, 2), tm, tn, r32, hi); store_T(SL(lds, 7), acc, tm, tn, r32, hi); }
    LDS_BAR();
#pragma unroll 1
    for (int k = 1; k <= 4; ++k) {
        const int yc = (k & 1) ? 5 : 8, ynx = (k & 1) ? 8 : 5, ttc = (k & 1) ? 13 : 14, ttn = (k & 1) ? 14 : 13;
        if (gr == 0) { mm_tile(Tt, SL(lds, yc), SL(lds, ttc), tm, tn, r32, hi); store_T(SL(lds, ttn), Tt, tm, tn, r32, hi); }
        else { f32x16 acc = (f32x16){}; mm_tile(acc, SL(lds, yc), SL(lds, yc + 1), tm, tn, r32, hi); store_R(SL(lds, ynx), acc, tm, tn, r32, hi); store_T(SL(lds, ynx + 1), acc, tm, tn, r32, hi); }
        LDS_BAR();
    }
    if (gr == 0) { mm_tile(Tt, SL(lds, 5), SL(lds, 13), tm, tn, r32, hi); store_R(SL(lds, 14), Tt, tm, tn, r32, hi); }
    else { mm_tile(hacc, SL(lds, 4), SL(lds, 2), tm, tn, r32, hi); mm_tile(yacc, SL(lds, 2), SL(lds, 12), tm, tn, r32, hi); }
    LDS_BAR();
    if (has_next) phaseA_loadWA(C, nb, nc, zwa);
    if (gr == 0) { f32x16 acc = (f32x16){}; mm_tile(acc, SL(lds, 14), SL(lds, 1), tm, tn, r32, hi); store_T(SL(lds, 8), acc, tm, tn, r32, hi); }
    else { f32x16 acc = (f32x16){}; mm_tile(acc, SL(lds, 14), SL(lds, 7), tm, tn, r32, hi); store_T(SL(lds, 9), acc, tm, tn, r32, hi); }
    LDS_BAR();
#if (DUPMASK >> 9) & 1
    if (gr == 0) { f32x16 acc = (f32x16){}; mm_tile(acc, SL(lds, 14), SL(lds, 1), tm, tn, r32, hi); store_T(SL(lds, 8), acc, tm, tn, r32, hi); }
    else { f32x16 acc = (f32x16){}; mm_tile(acc, SL(lds, 14), SL(lds, 7), tm, tn, r32, hi); store_T(SL(lds, 9), acc, tm, tn, r32, hi); }
    LDS_BAR();
#endif
    if (gr == 0) {
        f32x16 acc = (f32x16){}; mm_tile(acc, SL(lds, 8), SL(lds, 3), tm, tn, r32, hi);
        const float glc = GL[colg];
        int dm9 = colg - 32 * tm - 4 * hi; asm volatile("" : "+v"(dm9));
#pragma unroll
        for (int r = 0; r < 16; ++r) acc[r] = ((dm9 == CRW(r)) ? glc : 0.f) - acc[r];
        u32x4* gb = (u32x4*)(rec + REC_GB);
        gb[((tm * 2 + tn) * 2 + 0) * 64 + lane] = pack8(acc, 0); gb[((tm * 2 + tn) * 2 + 1) * 64 + lane] = pack8(acc, 1);
        acc = (f32x16){}; mm_tile(acc, SL(lds, 8), SL(lds, 11), tm, tn, r32, hi);
        const LAS bf16_t* Rt = (const LAS bf16_t*)SL(lds, 0);
#pragma unroll
        for (int g4 = 0; g4 < 4; ++g4) {
            const u32x2 w = *(const LAS u32x2*)(Rt + colg * LDB + 32 * tm + 8 * g4 + 4 * hi);
            acc[4 * g4] = bflo(w.x) - acc[4 * g4]; acc[4 * g4 + 1] = bfhi(w.x) - acc[4 * g4 + 1]; acc[4 * g4 + 2] = bflo(w.y) - acc[4 * g4 + 2]; acc[4 * g4 + 3] = bfhi(w.y) - acc[4 * g4 + 3];
        }
        u32x4* rb = (u32x4*)(rec + REC_RB);
        rb[((tm * 2 + tn) * 2 + 0) * 64 + lane] = pack8(acc, 0); rb[((tm * 2 + tn) * 2 + 1) * 64 + lane] = pack8(acc, 1);
    } else {
        f32x16 acc = (f32x16){}; mm_tile(acc, SL(lds, 3), SL(lds, 9), tm, tn, r32, hi);
#pragma unroll
        for (int r = 0; r < 16; ++r) hacc[r] -= acc[r];
        u32x4* hb = (u32x4*)(rec + REC_HB);
        hb[((tm * 2 + tn) * 2 + 0) * 64 + lane] = pack8(hacc, 0); hb[((tm * 2 + tn) * 2 + 1) * 64 + lane] = pack8(hacc, 1);
        acc = (f32x16){}; mm_tile(acc, SL(lds, 9), SL(lds, 11), tm, tn, r32, hi);
#pragma unroll
        for (int r = 0; r < 16; ++r) yacc[r] -= acc[r];
        u32x4* yb = (u32x4*)(rec + REC_YB);
        yb[((tm * 2 + tn) * 2 + 0) * 64 + lane] = pack8(yacc, 0); yb[((tm * 2 + tn) * 2 + 1) * 64 + lane] = pack8(yacc, 1);
    }
}

__device__ __forceinline__ void bc_state_pass(const Ctx& C, LAS char* lds, int u  ) {
    const int lane = C.lane, r32 = lane & 31, hi = lane >> 5, wid = C.wid, w4 = wid & 3, tp = w4 >> 1, tn = w4 & 1, grp = wid >> 2;
    f32x16 X = (f32x16){};
    LAS u32x4* PW = (LAS u32x4*)(lds + grp * 16384);
    const unsigned char* rec0 = C.CHK + (size_t)u * 32 * CHK_BYTES;
    u32x4 gbn[4], hbn[2];
    {
        const u32x4* gb = (const u32x4*)(rec0 + REC_GB); const u32x4* hb = (const u32x4*)(rec0 + REC_HB);
#pragma unroll
        for (int q = 0; q < 4; ++q) gbn[q] = gb[(((q >> 1) * 2 + tp) * 2 + (q & 1)) * 64 + lane];
        hbn[0] = hb[((tp * 2 + tn) * 2 + 0) * 64 + lane]; hbn[1] = hb[((tp * 2 + tn) * 2 + 1) * 64 + lane];
    }
#pragma unroll 1
    for (int c = 0; c < 32; ++c) {
        u32x4 gbc[4], hbc[2];
#pragma unroll
        for (int q = 0; q < 4; ++q) gbc[q] = gbn[q];
        hbc[0] = hbn[0]; hbc[1] = hbn[1];
        if (c + 1 < 32) {
            const unsigned char* rec = rec0 + (size_t)(c + 1) * CHK_BYTES;
            const u32x4* gb = (const u32x4*)(rec + REC_GB); const u32x4* hb = (const u32x4*)(rec + REC_HB);
#pragma unroll
            for (int q = 0; q < 4; ++q) gbn[q] = gb[(((q >> 1) * 2 + tp) * 2 + (q & 1)) * 64 + lane];
            hbn[0] = hb[((tp * 2 + tn) * 2 + 0) * 64 + lane]; hbn[1] = hb[((tp * 2 + tn) * 2 + 1) * 64 + lane];
        }
        const u32x4 p0 = pack8(X, 0), p1 = pack8(X, 1);
        LAS u32x4* pwb = PW + (c & 1) * 512;
        pwb[((tp * 2 + tn) * 2 + 0) * 64 + lane] = p0; pwb[((tp * 2 + tn) * 2 + 1) * 64 + lane] = p1;
        u32x4* s0 = (u32x4*)(C.S0R + ((size_t)u * 32 + c) * 8192);
        s0[((tp * 2 + tn) * 2 + 0) * 64 + lane] = p0; s0[((tp * 2 + tn) * 2 + 1) * 64 + lane] = p1;
        __syncthreads();
        f32x16 acc; unpack16(acc, hbc[0], hbc[1]);
#pragma unroll
        for (int q = 0; q < 4; ++q) {
            const u32x4 bw = pwb[(((q >> 1) * 2 + tn) * 2 + (q & 1)) * 64 + lane];
            acc = __builtin_amdgcn_mfma_f32_32x32x16_bf16(__builtin_bit_cast(bf16x8, gbc[q]), __builtin_bit_cast(bf16x8, bw), acc, 0, 0, 0);
        }
        X = acc;
    }
    float* so = C.out + O_WKVP + (size_t)u * 4096;
#pragma unroll
    for (int g4 = 0; g4 < 4; ++g4) *(f32x4*)(so + (32 * tn + r32) * 64 + 32 * tp + 8 * g4 + 4 * hi) = (f32x4){X[4 * g4], X[4 * g4 + 1], X[4 * g4 + 2], X[4 * g4 + 3]};
}

__device__ __forceinline__ void bc_output_wave(const Ctx& C, int u, int c, int tt, const LAS float* cst  ) {
    const int lane = C.lane, r32 = lane & 31, hi = lane >> 5, b = u >> 3, h = u & 7;
    const unsigned char* rec = C.CHK + ((size_t)u * 32 + c) * CHK_BYTES;
    const u32x4* rb = (const u32x4*)(rec + REC_RB); const u32x4* s0 = (const u32x4*)(C.S0R + ((size_t)u * 32 + c) * 8192);
    const bf16_t* PJ = C.PJ;
    const int t = c * 64 + 32 * tt + r32; const size_t m = (size_t)b * SEQ + t;
    u32x2 zv[8], zp[8], gt[8];
    const size_t mprev = m - (t > 0 ? 1 : 0);
#pragma unroll
    for (int q = 0; q < 8; ++q) {
        const int nn = h * 64 + 32 * (q >> 2) + 8 * (q & 3) + 4 * hi;
        zv[q] = *(const u32x2*)(PJ + m * NP + C_V + nn); zp[q] = *(const u32x2*)(PJ + mprev * NP + C_V + nn); gt[q] = *(const u32x2*)(PJ + m * NP + C_GR + nn);
    }
    const float bon = C.BONUS[m * 8 + h];
    f32x16 Y[2];
#pragma unroll
    for (int ti = 0; ti < 2; ++ti) {
        const u32x4* yb = (const u32x4*)(rec + REC_YB);
        f32x16 acc; unpack16(acc, yb[((ti * 2 + tt) * 2 + 0) * 64 + lane], yb[((ti * 2 + tt) * 2 + 1) * 64 + lane]);
#pragma unroll
        for (int tm = 0; tm < 2; ++tm)
#pragma unroll
            for (int sx = 0; sx < 2; ++sx)
                acc = __builtin_amdgcn_mfma_f32_32x32x16_bf16(__builtin_bit_cast(bf16x8, s0[((tm * 2 + ti) * 2 + sx) * 64 + lane]), __builtin_bit_cast(bf16x8, rb[((tm * 2 + tt) * 2 + sx) * 64 + lane]), acc, 0, 0, 0);
        Y[ti] = acc;
    }
    float s1 = 0.f;
#pragma unroll
    for (int r = 0; r < 16; ++r) s1 += Y[0][r] + Y[1][r];
    s1 += __shfl_xor(s1, 32);
    const float mean = s1 * (1.0f / 64.0f);
    float s2 = 0.f;
#pragma unroll
    for (int r = 0; r < 16; ++r) { const float d0 = Y[0][r] - mean, d1 = Y[1][r] - mean; s2 += d0 * d0 + d1 * d1; }
    s2 += __shfl_xor(s2, 32);
    const float rstd = 1.0f / sqrtf(s2 * (1.0f / 64.0f) + 64e-5f);
#pragma unroll
    for (int q = 0; q < 8; ++q) {
        const int ti = q >> 2, g4 = q & 3, nn = h * 64 + 32 * ti + 8 * g4 + 4 * hi;
        const f32x4 mu = *(const LAS f32x4*)(cst + nn), gw = *(const LAS f32x4*)(cst + 512 + nn), gb4 = *(const LAS f32x4*)(cst + 1024 + nn);
        const float v[4] = {bflo(zv[q].x), bfhi(zv[q].x), bflo(zv[q].y), bfhi(zv[q].y)};
        float vp[4] = {bflo(zp[q].x), bfhi(zp[q].x), bflo(zp[q].y), bfhi(zp[q].y)};
        if (t == 0) { vp[0] = 0.f; vp[1] = 0.f; vp[2] = 0.f; vp[3] = 0.f; }
        const float muv[4] = {mu.x, mu.y, mu.z, mu.w}, gate[4] = {bflo(gt[q].x), bfhi(gt[q].x), bflo(gt[q].y), bfhi(gt[q].y)}, gwv[4] = {gw.x, gw.y, gw.z, gw.w}, gbv[4] = {gb4.x, gb4.y, gb4.z, gb4.w};
        float o[4];
#pragma unroll
        for (int e = 0; e < 4; ++e) {
            const float vs = v[e] + (vp[e] - v[e]) * muv[e];
            const float yn = (Y[ti][4 * g4 + e] - mean) * rstd * gwv[e] + gbv[e] + bon * vs;
            o[e] = yn * fsilu(gate[e]);
        }
        u32x2 w; w.x = cvtpk(o[0], o[1]); w.y = cvtpk(o[2], o[3]);
        *(u32x2*)(C.MIX + m * DM + nn) = w;
    }
}
}

__device__ __forceinline__ void p2_rwkv_chunks(const Ctx& C, LAS unsigned char* lds) {
    u32x4 zwa[3];
    int it = C.bid;
    const int n_ = (C.bid & 7) * 64 + C.lane;
    const rk::ChanConst cc{C.w0[n_], C.a0[n_], C.k_k[n_], C.k_a[n_], C.r_k[n_], C.mu[C_R + n_], C.mu[C_K + n_], C.mu[C_V + n_], C.mu[C_WD + C.lane], C.mu[C_AD + C.lane]};
    if (it < BATCH * 8 * 32) rk::phaseA_loadWA(C, it >> 8, (it >> 3) & 31, zwa);
#pragma unroll 1
    for (; it < BATCH * 8 * 32; it += C.G) {
        const int nx = it + C.G; const bool hn = nx < BATCH * 8 * 32;
        rk::phaseA_item(C, (LAS char*)lds, it >> 8, it & 7, (it >> 3) & 31, zwa, hn, nx >> 8, (nx >> 3) & 31, cc);
    }
    __syncthreads();
}

namespace att {
constexpr int OFF_K = 0, OFF_V = 24576, OFF_IMP = 49152, IMP_LD = 129, OFF_SC = OFF_IMP + 64 * IMP_LD * 4, SC_LD = 33;
constexpr int OFF_STG = 49152;
constexpr int OFF_SEL = OFF_STG + 8 * 8192, OFF_WSF = OFF_SEL + 512, OFF_END = OFF_WSF + 8 * 64 * 4;
static_assert(OFF_SC + 64 * SC_LD * 4 <= OFF_SEL && OFF_END <= MISC_OFF, "attention LDS map");
__device__ __forceinline__ int crow(int r, int hi) { return (r & 3) + 8 * (r >> 2) + 4 * hi; }
__device__ __forceinline__ s16x4 vtr(const LAS char* p) {
    typedef short v4i16_t __attribute__((ext_vector_type(4)));
    return __builtin_bit_cast(s16x4, __builtin_amdgcn_ds_read_tr16_b64_v4i16((LAS v4i16_t*)p));
}
__device__ __forceinline__ void stage_kv(const bf16_t* Kg, const bf16_t* Vg, size_t pitch, int key0, LAS char* Ks, LAS char* Vs, int tid) {
    const int key = tid >> 3, ch = tid & 7;
    const u32x4 kv = *(const u32x4*)(Kg + (size_t)(key0 + key) * pitch + ch * 8);
    const u32x4 vv = *(const u32x4*)(Vg + (size_t)(key0 + key) * pitch + ch * 8);
    *(LAS u32x4*)(Ks + ch * 1024 + key * 16) = kv;
    *(LAS u32x4*)(Vs + (ch >> 2) * 4096 + key * 64 + (ch & 3) * 16) = vv;
}
__device__ __forceinline__ void qk(f32x16& p0, f32x16& p1, const LAS char* Ks, const bf16x8 (&qr)[4], int r32, int hi) {
    p0 = (f32x16){}; p1 = (f32x16){};
#pragma unroll
    for (int d0 = 0; d0 < 4; ++d0) {
        const bf16x8 a0 = *(const LAS bf16x8*)(Ks + (2 * d0 + hi) * 1024 + r32 * 16);
        const bf16x8 a1 = *(const LAS bf16x8*)(Ks + (2 * d0 + hi) * 1024 + 512 + r32 * 16);
        p0 = __builtin_amdgcn_mfma_f32_32x32x16_bf16(a0, qr[d0], p0, 0, 0, 0);
        p1 = __builtin_amdgcn_mfma_f32_32x32x16_bf16(a1, qr[d0], p1, 0, 0, 0);
    }
}
__device__ __forceinline__ int imax3(int a, int b, int c) { const int t = a > b ? a : b; return t > c ? t : c; }
__device__ __forceinline__ void pack_p(u32x4 (&pw)[4], const f32x16& p0, const f32x16& p1) {
    pw[0] = (u32x4){cvtpk(p0[0], p0[1]), cvtpk(p0[2], p0[3]), cvtpk(p0[4], p0[5]), cvtpk(p0[6], p0[7])};
    pw[1] = (u32x4){cvtpk(p0[8], p0[9]), cvtpk(p0[10], p0[11]), cvtpk(p0[12], p0[13]), cvtpk(p0[14], p0[15])};
    pw[2] = (u32x4){cvtpk(p1[0], p1[1]), cvtpk(p1[2], p1[3]), cvtpk(p1[4], p1[5]), cvtpk(p1[6], p1[7])};
    pw[3] = (u32x4){cvtpk(p1[8], p1[9]), cvtpk(p1[10], p1[11]), cvtpk(p1[12], p1[13]), cvtpk(p1[14], p1[15])};
}
__device__ __forceinline__ void pv_packed(f32x16 (&o)[2], const u32x4 (&pw)[4], const LAS char* Vs, int vbase) {
#pragma unroll
    for (int dt = 0; dt < 2; ++dt)
#pragma unroll
        for (int ks = 0; ks < 4; ++ks) {
            const s16x4 lo = vtr(Vs + vbase + dt * 4096 + ks * 1024), hi4 = vtr(Vs + vbase + dt * 4096 + ks * 1024 + 512);
            const bf16x8 vf = (bf16x8){lo[0], lo[1], lo[2], lo[3], hi4[0], hi4[1], hi4[2], hi4[3]};
            o[dt] = __builtin_amdgcn_mfma_f32_32x32x16_bf16(__builtin_bit_cast(bf16x8, pw[ks]), vf, o[dt], 0, 0, 0);
        }
}
__device__ __forceinline__ void accum_scaled(f32x16 (&ot)[2], const f32x16 (&o)[2], float fac, LAS float* wsf, int r32, int hi) {
    if (hi == 0) wsf[r32] = fac;
    asm volatile("s_waitcnt lgkmcnt(0)" ::: "memory");
#pragma unroll
    for (int r = 0; r < 16; ++r) { const float f = wsf[crow(r, hi)]; ot[0][r] += o[0][r] * f; ot[1][r] += o[1][r] * f; }
    asm volatile("s_waitcnt lgkmcnt(0)" ::: "memory");
}
struct KVRegs { u32x4 k, v; };
__device__ __forceinline__ KVRegs kv_load(const bf16_t* Kg, const bf16_t* Vg, size_t pitch, int key0, int tid) {
    const int key = tid >> 3, ch = tid & 7; KVRegs r;
    r.k = *(const u32x4*)(Kg + (size_t)(key0 + key) * pitch + ch * 8);
    r.v = *(const u32x4*)(Vg + (size_t)(key0 + key) * pitch + ch * 8);
    return r;
}
__device__ __forceinline__ void kv_store(const KVRegs& r, LAS char* Ks, LAS char* Vs, int tid) {
    const int key = tid >> 3, ch = tid & 7;
    *(LAS u32x4*)(Ks + ch * 1024 + key * 16) = r.k;
    *(LAS u32x4*)(Vs + (ch >> 2) * 4096 + key * 64 + (ch & 3) * 16) = r.v;
}
__device__ __forceinline__ float ex2(float x) { return __builtin_amdgcn_exp2f(x); }
__device__ __forceinline__ float hmax(float v) {
    const unsigned u = __float_as_uint(v);
    auto rr = __builtin_amdgcn_permlane32_swap(u, u, false, false);
    return fmaxf(__uint_as_float(rr[0]), __uint_as_float(rr[1]));
}
__device__ __forceinline__ float hsum(float v) {
    const unsigned u = __float_as_uint(v);
    auto rr = __builtin_amdgcn_permlane32_swap(u, u, false, false);
    return __uint_as_float(rr[0]) + __uint_as_float(rr[1]);
}
__device__ __forceinline__ void glds16(const void* gsrc, unsigned lds_dst) {
    unsigned keep;
    asm volatile("s_mov_b32 %0, m0\n\ts_mov_b32 m0, %2\n\ts_nop 0\n\tglobal_load_lds_dwordx4 %1, off\n\ts_mov_b32 m0, %0" : "=&s"(keep) : "v"(gsrc), "s"(lds_dst) : "memory");
}
__device__ __forceinline__ void k_dma(const bf16_t* Kg, size_t pitch, int key0, LAS char* Ks, int wid, int lane) {
    glds16(Kg + (size_t)(key0 + lane) * pitch + wid * 8, (unsigned)__builtin_amdgcn_readfirstlane((int)(unsigned)(uintptr_t)(Ks + wid * 1024)));
}
__device__ __forceinline__ void v_dma(const bf16_t* Vg, size_t pitch, int key0, LAS char* Vs, int wid, int lane) {
    glds16(Vg + (size_t)(key0 + 16 * (wid & 3) + (lane >> 2)) * pitch + (wid >> 2) * 32 + (lane & 3) * 8, (unsigned)__builtin_amdgcn_readfirstlane((int)(unsigned)(uintptr_t)(Vs + (wid >> 2) * 4096 + (wid & 3) * 1024)));
}
__device__ __forceinline__ int pop_bit(unsigned& m) { const int t = __builtin_ctz(m); m &= m - 1u; return t; }

__device__ __forceinline__ void attn_prompt_unit(const Ctx& C, LAS char* lds, int b, int kvh, int qb) {
    const int tid = C.tid, lane = C.lane, r32 = lane & 31, hi = lane >> 5, wid = C.wid;
    const int g = wid >> 1, th = wid & 1, h = kvh * 4 + g;
    const int t0 = qb * 64; const int tq = t0 + 32 * th + r32;
    const size_t mq = (size_t)b * SEQ + tq;
    const bf16_t* PJ = C.PJ;
    bf16x8 qr[4]; float gate0 = 0.f, gate1 = 0.f, gate2 = 0.f;
    LAS float* wsf = (LAS float*)(lds + OFF_WSF) + wid * 64;
    LAS float* stg = (LAS float*)(lds + OFF_STG) + wid * 2048;
    const int vbase = ((lane >> 4) & 1) * 32 + (lane & 3) * 8 + (4 * hi + ((lane & 15) >> 2)) * 64;
    LAS unsigned* selm = (LAS unsigned*)(lds + OFF_SEL);
    LAS float* imp = (LAS float*)(lds + OFF_IMP);
    const int jmax = (tq >= 31) ? ((tq - 31) >> 4) : -1;
    unsigned mysel = 0u, usel = 0u;
    const bf16x8 ones = (bf16x8){0x3F80, 0x3F80, 0x3F80, 0x3F80, 0x3F80, 0x3F80, 0x3F80, 0x3F80};
    unsigned mDs = 0u, mDw = 0u; int slot = 0;
    const bf16_t* Kg1 = PJ + (size_t)b * SEQ * NP + C_KV + 2 * 128 + kvh * 64;
#define DMA_NEXT12(RS) do { const bf16_t* base_; int t_; if (mDs) { t_ = pop_bit(mDs); base_ = Kg1; } else { t_ = pop_bit(mDw); base_ = Kg1 + 256; } \
        k_dma(base_, NP, t_ * 64, lds + OFF_K + (RS) * 8192, wid, lane); v_dma(base_ + 128, NP, t_ * 64, lds + OFF_V + (RS) * 8192, wid, lane); } while (0)
#pragma unroll 1
    for (int br = 0; br < 3; ++br) {
        const bf16_t* Kg; const bf16_t* Vg; size_t pitch; unsigned tmask;
        if (br == 0) { Kg = C.CMPK_P + (size_t)(b * 2 + kvh) * 128 * 64; Vg = C.CMPV_P + (size_t)(b * 2 + kvh) * 128 * 64; pitch = 64; tmask = 3u; }
        else { const int tlo = (qb - 8) > 0 ? (qb - 8) : 0; const unsigned wmask = ((2u << qb) - 1u) & ~((1u << tlo) - 1u);
               Kg = Kg1; Vg = Kg1; pitch = NP; if (br == 1) { tmask = usel; mDs = usel; mDw = wmask; } else tmask = wmask; }
        const int n = __builtin_popcount(tmask);
        unsigned mC = tmask, mD = tmask;
        float m_run = 0.f; f32x16 o[2], lacc, negm; o[0] = (f32x16){}; o[1] = (f32x16){}; lacc = (f32x16){}; negm = (f32x16){};
        if (br == 1) __builtin_amdgcn_s_waitcnt(0x0F70);
        asm volatile("s_waitcnt lgkmcnt(0)" ::: "memory"); __builtin_amdgcn_s_barrier(); asm volatile("" ::: "memory");
        if (br == 0) {
            { const int t = pop_bit(mD); k_dma(Kg, pitch, t * 64, lds + OFF_K, wid, lane); v_dma(Vg, pitch, t * 64, lds + OFF_V, wid, lane); }
            if (n > 1) { const int t = pop_bit(mD); k_dma(Kg, pitch, t * 64, lds + OFF_K + 8192, wid, lane); v_dma(Vg, pitch, t * 64, lds + OFF_V + 8192, wid, lane); }
            slot = 0;
        } else if (br == 1) { DMA_NEXT12(0); DMA_NEXT12(1); slot = 0; }
        if (br == 0) {
#pragma unroll
            for (int d0 = 0; d0 < 4; ++d0) qr[d0] = *(const bf16x8*)(PJ + mq * NP + C_Q + h * 64 + 16 * d0 + 8 * hi);
            const bf16_t g0 = PJ[mq * NP + C_GL + h], g1 = PJ[mq * NP + C_GL + 8 + h], g2 = PJ[mq * NP + C_GL + 16 + h];
            __builtin_amdgcn_s_waitcnt(0x0F70);
            gate0 = sigm(bf2f(g0)); gate1 = sigm(bf2f(g1)); gate2 = sigm(bf2f(g2));
        }
        const float gate = (br == 0) ? gate0 : (br == 1) ? gate1 : gate2;
#pragma unroll 1
        for (int i = 0; i < n; ++i) {
            if (br == 1 || i + 1 < n) asm volatile("s_waitcnt vmcnt(2)" ::: "memory"); else asm volatile("s_waitcnt vmcnt(0)" ::: "memory");
            __builtin_amdgcn_s_barrier(); asm volatile("" ::: "memory");
            { const int s2 = (slot == 0) ? 2 : slot - 1;
              if (br == 0) { if (i + 2 < n) { const int t = pop_bit(mD); k_dma(Kg, pitch, t * 64, lds + OFF_K + s2 * 8192, wid, lane); v_dma(Vg, pitch, t * 64, lds + OFF_V + s2 * 8192, wid, lane); } }
              else if (mDs | mDw) DMA_NEXT12(s2); }
            const int tcur = pop_bit(mC);
            const LAS char* Ks = lds + OFF_K + slot * 8192; const LAS char* Vs = lds + OFF_V + slot * 8192;
            bf16x8 ka[8];
#pragma unroll
            for (int d0 = 0; d0 < 4; ++d0) {
                ka[2 * d0] = *(const LAS bf16x8*)(Ks + (2 * d0 + hi) * 1024 + r32 * 16);
                ka[2 * d0 + 1] = *(const LAS bf16x8*)(Ks + (2 * d0 + hi) * 1024 + 512 + r32 * 16);
            }
            __builtin_amdgcn_sched_barrier(0);
            f32x16 c0 = negm, c1 = negm;
#pragma unroll
            for (int d0 = 0; d0 < 4; ++d0) {
                c0 = __builtin_amdgcn_mfma_f32_32x32x16_bf16(ka[2 * d0], qr[d0], c0, 0, 0, 0);
                c1 = __builtin_amdgcn_mfma_f32_32x32x16_bf16(ka[2 * d0 + 1], qr[d0], c1, 0, 0, 0);
            }
            bf16x8 vf[8];
#pragma unroll
            for (int f = 0; f < 8; ++f) {
                const s16x4 lo = vtr(Vs + vbase + f * 1024), hi4 = vtr(Vs + vbase + f * 1024 + 512);
                vf[f] = (bf16x8){lo[0], lo[1], lo[2], lo[3], hi4[0], hi4[1], hi4[2], hi4[3]};
            }
            __builtin_amdgcn_sched_barrier(0);
            int lim_hi, lim_lo = -1000000;
            if (br == 0) lim_hi = jmax - tcur * 64;
            else { lim_hi = tq - tcur * 64; if (br == 1) { if (!((mysel >> tcur) & 1u)) lim_hi = -1; } else lim_lo = lim_hi - 512; }
            const bool interior = __all((lim_hi >= 63) && (lim_lo < 0));
            if (!interior) {
                if (__all(((lim_hi >= 63) || (lim_hi < 0)) && (lim_lo < 0))) {
                    const bool vis = lim_hi >= 63;
#pragma unroll
                    for (int r = 0; r < 16; ++r) { c0[r] = vis ? c0[r] : -INFINITY; c1[r] = vis ? c1[r] : -INFINITY; }
                } else {
                    const int lh = lim_hi - 4 * hi, ll = lim_lo - 4 * hi;
                    if (__all(lim_lo < 0)) {
#pragma unroll
                        for (int r = 0; r < 16; ++r) { const int c = (r & 3) + 8 * (r >> 2); c0[r] = (c <= lh) ? c0[r] : -INFINITY; c1[r] = (c + 32 <= lh) ? c1[r] : -INFINITY; }
                    } else if (__all(lim_hi >= 63)) {
#pragma unroll
                        for (int r = 0; r < 16; ++r) { const int c = (r & 3) + 8 * (r >> 2); c0[r] = (c > ll) ? c0[r] : -INFINITY; c1[r] = (c + 32 > ll) ? c1[r] : -INFINITY; }
                    } else {
#pragma unroll
                        for (int r = 0; r < 16; ++r) {
                            const int c = (r & 3) + 8 * (r >> 2);
                            c0[r] = (c <= lh && c > ll) ? c0[r] : -INFINITY;
                            c1[r] = (c + 32 <= lh && c + 32 > ll) ? c1[r] : -INFINITY;
                        }
                    }
                }
            }
            int mi = (int)0x80000000;
#pragma unroll
            for (int r = 0; r < 16; ++r) { const float x0 = c0[r], x1 = c1[r]; mi = imax3(mi, __float_as_int(x0), __float_as_int(x1)); }
            if (i == 0 || __any(mi > 0x41000000)) {
                float mx = -INFINITY;
#pragma unroll
                for (int r = 0; r < 16; ++r) mx = fmaxf(mx, fmaxf(c0[r], c1[r]));
                mx = hmax(mx);
                const float d = (i == 0) ? ((mx == -INFINITY) ? 0.f : mx) : ((mx > 8.f) ? mx : 0.f);
                m_run += d;
#pragma unroll
                for (int r = 0; r < 16; ++r) { c0[r] -= d; c1[r] -= d; negm[r] = -m_run; }
                if (i > 0) {
                    if (hi == 0) wsf[r32] = ex2(-d);
                    asm volatile("s_waitcnt lgkmcnt(0)" ::: "memory");
                    f32x16 fv;
#pragma unroll
                    for (int r = 0; r < 16; ++r) fv[r] = wsf[crow(r, hi)];
                    o[0] *= fv; o[1] *= fv; lacc *= fv;
                    asm volatile("s_waitcnt lgkmcnt(0)" ::: "memory");
                }
            }
#define SB() __builtin_amdgcn_sched_barrier(0)
#define MF_L(P) lacc = __builtin_amdgcn_mfma_f32_32x32x16_bf16(__builtin_bit_cast(bf16x8, P), ones, lacc, 0, 0, 0)
#define MF_O(dt, P, f) o[dt] = __builtin_amdgcn_mfma_f32_32x32x16_bf16(__builtin_bit_cast(bf16x8, P), vf[f], o[dt], 0, 0, 0)
#pragma unroll
            for (int r = 0; r < 16; ++r) c0[r] = ex2(c0[r]);
            const u32x4 pw0 = (u32x4){cvtpk(c0[0], c0[1]), cvtpk(c0[2], c0[3]), cvtpk(c0[4], c0[5]), cvtpk(c0[6], c0[7])};
            const u32x4 pw1 = (u32x4){cvtpk(c0[8], c0[9]), cvtpk(c0[10], c0[11]), cvtpk(c0[12], c0[13]), cvtpk(c0[14], c0[15])};
            u32x4 pw2, pw3;
            SB(); MF_L(pw0); SB(); c1[0] = ex2(c1[0]); c1[1] = ex2(c1[1]); c1[2] = ex2(c1[2]);
            SB(); MF_O(0, pw0, 0); SB(); c1[3] = ex2(c1[3]); c1[4] = ex2(c1[4]); c1[5] = ex2(c1[5]);
            SB(); MF_O(1, pw0, 4); SB(); c1[6] = ex2(c1[6]); c1[7] = ex2(c1[7]); pw2.x = cvtpk(c1[0], c1[1]); pw2.y = cvtpk(c1[2], c1[3]);
            SB(); MF_L(pw1); SB(); pw2.z = cvtpk(c1[4], c1[5]); pw2.w = cvtpk(c1[6], c1[7]); c1[8] = ex2(c1[8]); c1[9] = ex2(c1[9]);
            SB(); MF_O(0, pw1, 1); SB(); c1[10] = ex2(c1[10]); c1[11] = ex2(c1[11]); c1[12] = ex2(c1[12]);
            SB(); MF_O(1, pw1, 5); SB(); c1[13] = ex2(c1[13]); c1[14] = ex2(c1[14]); c1[15] = ex2(c1[15]);
            pw3 = (u32x4){cvtpk(c1[8], c1[9]), cvtpk(c1[10], c1[11]), cvtpk(c1[12], c1[13]), cvtpk(c1[14], c1[15])};
            SB(); MF_L(pw2); MF_O(0, pw2, 2); MF_O(1, pw2, 6); MF_L(pw3); MF_O(0, pw3, 3); MF_O(1, pw3, 7);
#undef SB
#undef MF_L
#undef MF_O
            slot = (slot == 2) ? 0 : slot + 1;
        }
        asm volatile("s_waitcnt lgkmcnt(0)" ::: "memory");
        if (br == 0) {
            int tid_o = C.tid; asm volatile("" : "+v"(tid_o));
            const int tid = tid_o, lane = tid & 63, r32 = lane & 31, hi = lane >> 5;
            if (qb < 16) {
                LDS_BAR();
                if (tid <= 64) selm[tid] = (2u << qb) - 1u;
            } else {
#pragma unroll
                for (int r = 0; r < 16; ++r) wsf[crow(r, hi)] = lacc[r];
                asm volatile("s_waitcnt lgkmcnt(0)" ::: "memory");
                const float lrow = wsf[r32];
                asm volatile("s_waitcnt lgkmcnt(0)" ::: "memory");
                const float invl = lrow > 0.f ? 1.0f / lrow : 0.f;
#pragma unroll 1
                for (int t2 = 0; t2 < 2; ++t2) {
                    f32x16 p0 = negm, p1 = negm;
                    {
                        const LAS char* Ks = lds + OFF_K + t2 * 8192;
                        bf16x8 ka[8];
#pragma unroll
                        for (int d0 = 0; d0 < 4; ++d0) {
                            ka[2 * d0] = *(const LAS bf16x8*)(Ks + (2 * d0 + hi) * 1024 + r32 * 16);
                            ka[2 * d0 + 1] = *(const LAS bf16x8*)(Ks + (2 * d0 + hi) * 1024 + 512 + r32 * 16);
                        }
                        __builtin_amdgcn_sched_barrier(0);
#pragma unroll
                        for (int d0 = 0; d0 < 4; ++d0) {
                            p0 = __builtin_amdgcn_mfma_f32_32x32x16_bf16(ka[2 * d0], qr[d0], p0, 0, 0, 0);
                            p1 = __builtin_amdgcn_mfma_f32_32x32x16_bf16(ka[2 * d0 + 1], qr[d0], p1, 0, 0, 0);
                        }
                    }
                    const int lh = jmax - t2 * 64 - 4 * hi;
#pragma unroll
                    for (int r = 0; r < 16; ++r) {
                        const int c = (r & 3) + 8 * (r >> 2);
                        p0[r] = (c <= lh) ? ex2(p0[r]) * invl : 0.f;
                        p1[r] = (c + 32 <= lh) ? ex2(p1[r]) * invl : 0.f;
                    }
#pragma unroll 1
                    for (int gg = 0; gg < 4; ++gg) {
                        if (g == gg) {
#pragma unroll
                            for (int r = 0; r < 16; ++r) {
                                const int idx = (32 * th + r32) * IMP_LD + t2 * 64 + crow(r, hi);
                                if (gg == 0) { imp[idx] = p0[r]; imp[idx + 32] = p1[r]; }
                                else { imp[idx] += p0[r]; imp[idx + 32] += p1[r]; }
                            }
                        }
                        LDS_BAR();
                    }
                }
                LAS float* sc = (LAS float*)(lds + OFF_SC);
                const int tl = tid >> 3, sub = tid & 7;
                float my[4];
#pragma unroll
                for (int k = 0; k < 4; ++k) {
                    const int sx = sub * 4 + k; float v = 0.f;
#pragma unroll
                    for (int j = 4 * sx - 1; j <= 4 * sx + 3; ++j) if (j >= 0 && j <= 126) v += imp[tl * IMP_LD + j];
                    if (sx > qb) v = -1e4f; else if (sx == 0 || sx == qb || sx == qb - 1) v += 1e4f;
                    my[k] = v; sc[tl * SC_LD + sx] = v;
                }
                LDS_BAR();
                unsigned bits = 0u;
#pragma unroll
                for (int k = 0; k < 4; ++k) {
                    const int sx = sub * 4 + k; int rank = 0;
                    for (int s2 = 0; s2 < 32; ++s2) { const float ov = sc[tl * SC_LD + s2]; rank += ((ov > my[k]) || (ov == my[k] && s2 < sx)) ? 1 : 0; }
                    if (rank < 16 && sx <= qb) bits |= 1u << sx;
                }
                bits |= __shfl_xor(bits, 1); bits |= __shfl_xor(bits, 2); bits |= __shfl_xor(bits, 4);
                if (sub == 0) selm[tl] = bits;
                unsigned wb = bits; wb |= __shfl_xor(wb, 8); wb |= __shfl_xor(wb, 16); wb |= __shfl_xor(wb, 32);
                if (lane == 0) selm[72 + wid] = wb;
            }
            LDS_BAR();
            mysel = selm[32 * th + r32];
            if (qb < 16) usel = selm[64];
            else { const u32x4 wa = *(const LAS u32x4*)(selm + 72), wb4 = *(const LAS u32x4*)(selm + 76); usel = (wa.x | wa.y) | (wa.z | wa.w) | (wb4.x | wb4.y) | (wb4.z | wb4.w); }
            usel = (unsigned)__builtin_amdgcn_readfirstlane((int)usel);
        }
        {
        int lane_o = C.lane; asm volatile("" : "+v"(lane_o));
        const int r32 = lane_o & 31, hi = lane_o >> 5;
        if (hi == 0) wsf[r32] = gate;
        asm volatile("s_waitcnt lgkmcnt(0)" ::: "memory");
        if (br == 0) {
#pragma unroll
            for (int r = 0; r < 16; ++r) { const float f = wsf[crow(r, hi)] * ((lacc[r] > 0.f) ? __builtin_amdgcn_rcpf(lacc[r]) : 0.f); stg[crow(r, hi) * 64 + r32] = o[0][r] * f; stg[crow(r, hi) * 64 + 32 + r32] = o[1][r] * f; }
        } else {
#pragma unroll
            for (int r = 0; r < 16; ++r) { const float f = wsf[crow(r, hi)] * ((lacc[r] > 0.f) ? __builtin_amdgcn_rcpf(lacc[r]) : 0.f); stg[crow(r, hi) * 64 + r32] += o[0][r] * f; stg[crow(r, hi) * 64 + 32 + r32] += o[1][r] * f; }
        }
        asm volatile("s_waitcnt lgkmcnt(0)" ::: "memory");
        }
    }
#undef DMA_NEXT12
    {
        int le = lane; asm volatile("" : "+v"(le));
#pragma unroll
        for (int k = 0; k < 4; ++k) {
            const int row = k * 8 + (le >> 3), ch = le & 7;
            const size_t m = (size_t)b * SEQ + t0 + 32 * th + row;
            const f32x4 x0 = *(const LAS f32x4*)(stg + row * 64 + ch * 8), x1 = *(const LAS f32x4*)(stg + row * 64 + ch * 8 + 4);
            const u32x4 gw4 = *(const u32x4*)(PJ + m * NP + C_GN + h * 64 + ch * 8);
            float gf[8]; unpack8(gw4, gf);
            u32x4 w; w.x = cvtpk(x0.x * fsilu(gf[0]), x0.y * fsilu(gf[1])); w.y = cvtpk(x0.z * fsilu(gf[2]), x0.w * fsilu(gf[3]));
            w.z = cvtpk(x1.x * fsilu(gf[4]), x1.y * fsilu(gf[5])); w.w = cvtpk(x1.z * fsilu(gf[6]), x1.w * fsilu(gf[7]));
            *(u32x4*)(C.MIX + m * DM + 512 + h * 64 + ch * 8) = w;
        }
        asm volatile("s_waitcnt lgkmcnt(0)" ::: "memory");
    }
    LDS_BAR();
}

constexpr int SLD = 1040;
__device__ __forceinline__ void softmax_row(LAS float* s, int n, int lane) {
    float mx = -INFINITY;
    for (int j = lane; j < n; j += 64) mx = fmaxf(mx, s[j]);
    mx = wave_max_dpp(mx);
    float sm = 0.f;
    for (int j = lane; j < n; j += 64) { const float e = __builtin_amdgcn_exp2f(s[j] - mx); s[j] = e; sm += e; }
    sm = wave_sum_dpp(sm);
    const float inv = 1.0f / sm;
    for (int j = lane; j < n; j += 64) s[j] *= inv;
    asm volatile("s_waitcnt lgkmcnt(0)" ::: "memory");
}
__device__ __forceinline__ void load_key_f32(const float* p, float (&kf)[64]) {
#pragma unroll
    for (int i = 0; i < 16; ++i) { const f32x4 q = *(const f32x4*)(p + 4 * i); kf[4 * i] = q.x; kf[4 * i + 1] = q.y; kf[4 * i + 2] = q.z; kf[4 * i + 3] = q.w; }
}
__device__ __forceinline__ void load_key_bf16(const bf16_t* p, float (&kf)[64]) {
#pragma unroll
    for (int i = 0; i < 8; ++i) { const u32x4 q = *(const u32x4*)(p + 8 * i); unpack8(q, &kf[8 * i]); }
}
__device__ __forceinline__ float dot64(const float (&kf)[64], const LAS float* q) {
    float a0 = 0.f, a1 = 0.f;
#pragma unroll
    for (int i = 0; i < 16; ++i) { const f32x4 v = *(const LAS f32x4*)(q + 4 * i); a0 += kf[4 * i] * v.x + kf[4 * i + 2] * v.z; a1 += kf[4 * i + 1] * v.y + kf[4 * i + 3] * v.w; }
    return a0 + a1;
}
__device__ __forceinline__ f32x4 ld4_bf16(const bf16_t* p) { const u32x2 w = *(const u32x2*)p; return (f32x4){bflo(w.x), bfhi(w.x), bflo(w.y), bfhi(w.y)}; }
template <int KPS, class VL>
__device__ __forceinline__ void pv_valu(const LAS float* S, int nkeys, const VL& vload, LAS float* part, LAS float* outp, int tid) {
    const int ksub = tid >> 4, d4 = tid & 15;
    f32x4 acc[4];
#pragma unroll
    for (int g = 0; g < 4; ++g) acc[g] = (f32x4){0.f, 0.f, 0.f, 0.f};
#pragma unroll 16
    for (int i = 0; i < KPS; ++i) {
        const int kk = ksub * KPS + i;
        if (kk < nkeys) {
            const f32x4 v = vload(kk, d4);
#pragma unroll
            for (int g = 0; g < 4; ++g) acc[g] += v * S[g * SLD + kk];
        }
    }
#pragma unroll
    for (int g = 0; g < 4; ++g) *(LAS f32x4*)(part + (ksub * 4 + g) * 64 + d4 * 4) = acc[g];
    __syncthreads();
    if (tid < 256) { float r = 0.f;
#pragma unroll 8
        for (int k2 = 0; k2 < 32; ++k2) r += part[(k2 * 4 + (tid >> 6)) * 64 + (tid & 63)];
        outp[tid] = r; }
    __syncthreads();
}
__device__ __forceinline__ float dot64_bf16(const u32x4 (&k)[8], const LAS float* q) {
    float a0 = 0.f, a1 = 0.f;
#pragma unroll
    for (int i = 0; i < 8; ++i) {
        const f32x4 q0 = *(const LAS f32x4*)(q + 8 * i), q1 = *(const LAS f32x4*)(q + 8 * i + 4);
        a0 += bflo(k[i].x) * q0.x + bflo(k[i].y) * q0.z + bflo(k[i].z) * q1.x + bflo(k[i].w) * q1.z;
        a1 += bfhi(k[i].x) * q0.y + bfhi(k[i].y) * q0.w + bfhi(k[i].z) * q1.y + bfhi(k[i].w) * q1.w;
    }
    return a0 + a1;
}
__device__ __forceinline__ float dot64_f32(const f32x4 (&k)[16], const LAS float* q) {
    float a0 = 0.f, a1 = 0.f;
#pragma unroll
    for (int i = 0; i < 16; ++i) { const f32x4 v = *(const LAS f32x4*)(q + 4 * i); a0 += k[i].x * v.x + k[i].z * v.z; a1 += k[i].y * v.y + k[i].w * v.w; }
    return a0 + a1;
}
constexpr int WLD = 576;
__device__ __forceinline__ void attn_sample_unit(const Ctx& C, LAS char* lds, int b, int kvh, int t) {
    int tid_o = C.tid; asm volatile("" : "+v"(tid_o));
    const int tid = tid_o, lane = tid & 63, wid = __builtin_amdgcn_readfirstlane(tid >> 6);
    LAS float* Qs = (LAS float*)lds;
    LAS float* S = (LAS float*)(lds + 1024);
    LAS float* W = (LAS float*)(lds + 17664);
    LAS float* scS = (LAS float*)(lds + 26880);
    LAS int* idxS = (LAS int*)(lds + 27920);
    LAS int* rowidx = (LAS int*)(lds + 27984);
    LAS float* part = (LAS float*)(lds + 32256);
    LAS float* part2 = (LAS float*)(lds + 65024);
    LAS float* outS = (LAS float*)(lds + 97792);
    const int msb = MP + b * 4; const size_t m = (size_t)(msb + t);
    const bf16_t* PJ = C.PJ;
    __syncthreads();
    if (tid < 256) Qs[tid] = bf2f(PJ[m * NP + C_Q + (kvh * 4 + (tid >> 6)) * 64 + (tid & 63)]);
    if (tid < 4) S[tid * SLD + 1023] = -INFINITY;
    {
        u32x4 c0[8], c1[8];
        const bf16_t* kp = C.CMPK_S + ((size_t)(b * 2 + kvh) * 1024) * 64;
        const int j1 = (tid + 512 < 1023) ? tid + 512 : 1022;
#pragma unroll
        for (int i = 0; i < 8; ++i) { c0[i] = *(const u32x4*)(kp + (size_t)tid * 64 + 8 * i); c1[i] = *(const u32x4*)(kp + (size_t)j1 * 64 + 8 * i); }
        __syncthreads();
#pragma unroll 1
        for (int g = 0; g < 4; ++g) {
            S[g * SLD + tid] = dot64_bf16(c0, Qs + g * 64);
            if (tid + 512 < 1023) S[g * SLD + tid + 512] = dot64_bf16(c1, Qs + g * 64);
        }
    }
    {
        f32x4 wk[16];
        const float* wp = C.win + ((size_t)(b * 512 + tid) * 2 + 0) * 128 + kvh * 64;
#pragma unroll
        for (int i = 0; i < 16; ++i) wk[i] = *(const f32x4*)(wp + 4 * i);
#pragma unroll 1
        for (int g = 0; g < 4; ++g) { const float a = dot64_f32(wk, Qs + g * 64); W[g * WLD + tid] = (tid > t) ? a : -INFINITY; }
        if (tid < 64) {
            const int i = 512 + tid;
            if (tid < 4) {
                float kf[64]; load_key_bf16(PJ + (size_t)(msb + tid) * NP + C_KV + 4 * 128 + kvh * 64, kf);
#pragma unroll 1
                for (int g = 0; g < 4; ++g) { const float a = dot64(kf, Qs + g * 64); W[g * WLD + i] = (tid <= t) ? a : -INFINITY; }
            } else {
#pragma unroll
                for (int g = 0; g < 4; ++g) W[g * WLD + i] = -INFINITY;
            }
        }
    }
    __syncthreads();
    if (wid < 4) softmax_row(S + wid * SLD, 1024, lane); else softmax_row(W + (wid - 4) * WLD, WLD, lane);
    __syncthreads();
    if (tid < 257) {
        const int s = tid; float v = 0.f;
        for (int j = 4 * s - 1; j <= 4 * s + 3; ++j) if (j >= 0 && j < 1023) v += ((S[j] + S[SLD + j]) + S[2 * SLD + j]) + S[3 * SLD + j];
        if (s == 0 || s == 255 || s == 256) v += 1e4f;
        scS[s] = v;
    }
    {
        const int ksub = tid >> 4, d4 = tid & 15;
        const bf16_t* vb = C.CMPV_S + (size_t)(b * 2 + kvh) * 1024 * 64 + d4 * 4;
        const float* wv = C.win + ((size_t)(b * 512) * 2 + 1) * 128 + kvh * 64 + d4 * 4;
        f32x4 ac[4], aw[4];
#pragma unroll
        for (int g = 0; g < 4; ++g) { ac[g] = (f32x4){0.f, 0.f, 0.f, 0.f}; aw[g] = ac[g]; }
#pragma unroll 8
        for (int i = 0; i < 32; ++i) {
            const int kk = ksub * 32 + i; const f32x4 v = ld4_bf16(vb + (size_t)kk * 64);
#pragma unroll
            for (int g = 0; g < 4; ++g) ac[g] += v * S[g * SLD + kk];
        }
#pragma unroll 6
        for (int i = 0; i < 17; ++i) {
            const int kk = ksub * 17 + i;
            if (kk < 516) {
                const f32x4 v = (kk < 512) ? *(const f32x4*)(wv + (size_t)kk * 256) : ld4_bf16(PJ + (size_t)(msb + kk - 512) * NP + C_KV + 5 * 128 + kvh * 64 + d4 * 4);
#pragma unroll
                for (int g = 0; g < 4; ++g) aw[g] += v * W[g * WLD + kk];
            }
        }
#pragma unroll
        for (int g = 0; g < 4; ++g) { *(LAS f32x4*)(part + (ksub * 4 + g) * 64 + d4 * 4) = ac[g]; *(LAS f32x4*)(part2 + (ksub * 4 + g) * 64 + d4 * 4) = aw[g]; }
    }
    __syncthreads();
    {
        const LAS float* pp = (tid < 256) ? part : part2; const int q = tid & 255; float r = 0.f;
#pragma unroll 8
        for (int k2 = 0; k2 < 32; ++k2) r += pp[(k2 * 4 + (q >> 6)) * 64 + (q & 63)];
        outS[(tid < 256 ? 0 : 512) + q] = r;
    }
    if (tid < 257) {
        const float mine = scS[tid]; int rank = 0;
        for (int s2 = 0; s2 < 257; ++s2) { const float ov = scS[s2]; rank += ((ov > mine) || (ov == mine && s2 < tid)) ? 1 : 0; }
        if (rank < 16) idxS[rank] = tid;
    }
    __syncthreads();
    for (int kk = tid; kk < 1024; kk += 512) {
        const int blk = idxS[kk >> 6], r = kk & 63; int ri;
        if (blk < 256) { const int pg = C.pt[b * 128 + (blk >> 1)]; ri = pg * 128 + (blk & 1) * 64 + r; } else ri = -1 - r;
        rowidx[kk] = ri;
    }
    __syncthreads();
#pragma unroll 1
    for (int kk = tid; kk < 1024; kk += 512) {
        const int ri = rowidx[kk]; float kf[64]; bool valid = true;
        if (ri >= 0) load_key_f32(C.cache + (size_t)ri * 512 + 2 * 128 + kvh * 64, kf);
        else {
            const int r = -1 - ri; valid = (r <= t);
            if (r < 4) load_key_bf16(PJ + (size_t)(msb + r) * NP + C_KV + 2 * 128 + kvh * 64, kf);
            else {
#pragma unroll
                for (int d = 0; d < 64; ++d) kf[d] = 0.f;
            }
        }
#pragma unroll 1
        for (int g = 0; g < 4; ++g) { const float a = dot64(kf, Qs + g * 64); S[g * SLD + kk] = valid ? a : -INFINITY; }
    }
    __syncthreads();
    if (wid < 4) softmax_row(S + wid * SLD, 1024, lane);
    __syncthreads();
    {
        auto vl = [&](int kk, int d4) {
            const int ri = rowidx[kk];
            if (ri >= 0) return *(const f32x4*)(C.cache + (size_t)ri * 512 + 3 * 128 + kvh * 64 + d4 * 4);
            const int r = -1 - ri;
            if (r < 4) return ld4_bf16(PJ + (size_t)(msb + r) * NP + C_KV + 3 * 128 + kvh * 64 + d4 * 4);
            return (f32x4){0.f, 0.f, 0.f, 0.f};
        };
        pv_valu<32>(S, 1024, vl, part, outS + 256, tid);
    }
    if (tid < 256) {
        const int g = tid >> 6, d = tid & 63, h = kvh * 4 + g;
        const float g0 = sigm(bf2f(PJ[m * NP + C_GL + h])), g1 = sigm(bf2f(PJ[m * NP + C_GL + 8 + h])), g2 = sigm(bf2f(PJ[m * NP + C_GL + 16 + h]));
        const float o = g0 * outS[tid] + g1 * outS[256 + tid] + g2 * outS[512 + tid];
        const float gn = bf2f(PJ[m * NP + C_GN + h * 64 + d]);
        C.MIX[m * DM + 512 + h * 64 + d] = f2bf(o * silu(gn));
    }
    __syncthreads();
}
}

__device__ __forceinline__ void p4_attention(const Ctx& C, LAS unsigned char* lds) {
    unsigned* qctr = (unsigned*)(C.ws + WS_CTL) + 64;
    volatile LAS unsigned* slot = (volatile LAS unsigned*)(lds + MISC_OFF) + 16;
    int nxt = 0;
#define Q_ISSUE() do { if (C.tid == 0) nxt = (int)__hip_atomic_fetch_add(qctr, 1u, __ATOMIC_RELAXED, __HIP_MEMORY_SCOPE_AGENT); } while (0)
#define Q_TAKE(dst) do { LDS_BAR(); if (C.tid == 0) slot[0] = (unsigned)nxt; LDS_BAR(); dst = (int)slot[0]; } while (0)
    int id;
    unsigned* sdone = (unsigned*)(C.ws + WS_CTL) + 192;
    if (C.bid < 64) {
        rk::bc_state_pass(C, (LAS char*)lds, C.bid * 2 + (C.wid >> 2));
        asm volatile("s_waitcnt vmcnt(0)" ::: "memory");
        __syncthreads();
        if (C.tid == 0) { __builtin_amdgcn_fence(__ATOMIC_RELEASE, "agent"); asm volatile("s_waitcnt vmcnt(0)" ::: "memory"); __hip_atomic_fetch_add(sdone, 1u, __ATOMIC_RELAXED, __HIP_MEMORY_SCOPE_AGENT); }
    } else if (C.bid < 96) rwkv_sample_unit(C, C.bid - 64, C.wid, (LAS float*)(lds + C.wid * 8704));
    __syncthreads();
    constexpr int RP = 1 + ((DUPMASK >> 12) & 1), RO = 1 + ((DUPMASK >> 14) & 1);
    constexpr int NQ_P = 1024 * RP, NQ_O = 1024 * RO;
    if (C.bid & 1) {
        unsigned* qc2 = (unsigned*)(C.ws + WS_CTL) + 128;
        load_cmp_consts(C, lds);
        CmpW W; load_cmp_w(C, W);
        RowsSample R{C.cache, C.pt};
#pragma unroll 1
        for (;;) {
            __syncthreads(); if (C.tid == 0) slot[0] = __hip_atomic_fetch_add(qc2, 1u, __ATOMIC_RELAXED, __HIP_MEMORY_SCOPE_AGENT); __syncthreads();
            const int q = (int)slot[0]; if (q >= 1024) break;
            const int b = q >> 5, j0 = (q & 31) * 32; const int nj = (1023 - j0) < 32 ? (1023 - j0) : 32;
            compress_item(R, b, j0, nj, lds, C.CMPK_S, C.CMPV_S, 1024, C.tid, C.lane, C.wid, W);
        }
        __builtin_amdgcn_s_waitcnt(0x0F70);
    }
    Q_ISSUE(); Q_TAKE(id);
#pragma unroll 1
    while (id < NQ_P) { Q_ISSUE(); const int q = id & 1023, qb = 31 - (q >> 5), bk = q & 31; att::attn_prompt_unit(C, (LAS char*)lds, bk >> 1, bk & 1, qb); Q_TAKE(id); }
    if (id < NQ_P + NQ_O) {
        if (C.tid == 0) {
            unsigned sp = 0;
            while (__hip_atomic_load(sdone, __ATOMIC_RELAXED, __HIP_MEMORY_SCOPE_AGENT) < 64u) { __builtin_amdgcn_s_sleep(4); if (++sp > (1u << 22)) break; }
            __builtin_amdgcn_fence(__ATOMIC_ACQUIRE, "agent");
            asm volatile("s_waitcnt vmcnt(0)" ::: "memory");
        }
        __syncthreads();
    }
    LAS float* cst = (LAS float*)lds;
    if (id < NQ_P + NQ_O) {
        for (int i = C.tid; i < 512; i += 512) { cst[i] = C.mu[C_V + i]; cst[512 + i] = C.gn_w[i]; cst[1024 + i] = C.gn_b[i]; }
        __syncthreads();
    }
#pragma unroll 1
    while (id < NQ_P + NQ_O) { Q_ISSUE(); const int p = (id - NQ_P) & 1023; rk::bc_output_wave(C, p >> 3, (p & 7) * 4 + (C.wid >> 1), C.wid & 1, cst); Q_TAKE(id); }
    for (int i = C.bid * 512 + C.tid; i < DECB * 2 * 64; i += C.G * 512) { const int bk = i >> 6, d = i & 63; C.CMPK_S[((size_t)bk * 1024 + 1023) * 64 + d] = 0; C.CMPV_S[((size_t)bk * 1024 + 1023) * 64 + d] = 0; }
#undef Q_ISSUE
#undef Q_TAKE
}

__device__ __forceinline__ void p5_sample_attention(const Ctx& C, LAS unsigned char* lds) {
    constexpr int RS = 1 + ((DUPMASK >> 13) & 1);
    for (int p = C.bid; p < 256 * RS; p += C.G) { const int u = p & 255; att::attn_sample_unit(C, (LAS char*)lds, u >> 3, (u >> 2) & 1, u & 3); }
}

__device__ __forceinline__ void p6_final_norm(const Ctx& C) {
    f32x4 gq[4];
#pragma unroll
    for (int j = 0; j < 4; ++j) gq[j] = *(const f32x4*)(C.final_g + 4 * (C.lane + 64 * j));
    const bf16_t* yb = (const bf16_t*)(C.ws + WS_YB);
    for (int m4 = C.gw * 4; m4 < MP; m4 += C.NGW * 4) {
        f32x4 v[4][4]; float rs[4];
#pragma unroll
        for (int q = 0; q < 4; ++q)
#pragma unroll
            for (int j = 0; j < 4; ++j) { const u32x2 w = *(const u32x2*)(yb + (size_t)(m4 + q) * DM + 4 * (C.lane + 64 * j)); v[q][j] = (f32x4){bflo(w.x), bfhi(w.x), bflo(w.y), bfhi(w.y)}; }
#pragma unroll
        for (int q = 0; q < 4; ++q) {
            float a = 0.f;
#pragma unroll
            for (int j = 0; j < 4; ++j) a += (v[q][j].x * v[q][j].x + v[q][j].y * v[q][j].y) + (v[q][j].z * v[q][j].z + v[q][j].w * v[q][j].w);
            rs[q] = 1.0f / sqrtf(wave_sum_dpp(a) * (1.0f / DM) + 1e-6f);
        }
#pragma unroll
        for (int q = 0; q < 4; ++q)
#pragma unroll
            for (int j = 0; j < 4; ++j) *(f32x4*)(C.out + (size_t)(m4 + q) * DM + 4 * (C.lane + 64 * j)) = v[q][j] * rs[q] * gq[j];
    }
    for (int m = MP + C.gw; m < MTOT; m += C.NGW) {
        float* y = C.out + (size_t)m * DM; f32x4 v[4]; float a = 0.f;
#pragma unroll
        for (int j = 0; j < 4; ++j) { v[j] = *(const f32x4*)(y + 4 * (C.lane + 64 * j)); a += (v[j].x * v[j].x + v[j].y * v[j].y) + (v[j].z * v[j].z + v[j].w * v[j].w); }
        const float rs = 1.0f / sqrtf(wave_sum_dpp(a) * (1.0f / DM) + 1e-6f);
#pragma unroll
        for (int j = 0; j < 4; ++j) *(f32x4*)(y + 4 * (C.lane + 64 * j)) = v[j] * rs * gq[j];
    }
}

struct Args { const void* in[23]; float* out; unsigned char* ws; int ph_lo, ph_hi; };
constexpr int N_PHASES = 8;
__global__ void __launch_bounds__(512, 2) fwd(Args args) {
    extern __shared__ __attribute__((aligned(16))) unsigned char lds_raw[];
    LAS unsigned char* lds = (LAS unsigned char*)lds_raw;
    Ctx C;
    C.xp = (const float*)args.in[0]; C.xs = (const float*)args.in[1]; C.cache = (const float*)args.in[2]; C.win = (const float*)args.in[3];
    C.swkv = (const float*)args.in[4]; C.sshift = (const float*)args.in[5]; C.pt = (const int*)args.in[6];
    C.norm_g = (const float*)args.in[7]; C.w_in = (const float*)args.in[8]; C.mu = (const float*)args.in[9]; C.w0 = (const float*)args.in[10];
    C.wdu = (const float*)args.in[11]; C.a0 = (const float*)args.in[12]; C.wau = (const float*)args.in[13]; C.k_k = (const float*)args.in[14];
    C.k_a = (const float*)args.in[15]; C.r_k = (const float*)args.in[16]; C.gn_w = (const float*)args.in[17]; C.gn_b = (const float*)args.in[18];
    C.wpos = (const float*)args.in[19]; C.wmix = (const float*)args.in[20]; C.w_out = (const float*)args.in[21]; C.final_g = (const float*)args.in[22];
    C.out = args.out; C.ws = args.ws;
    unsigned char* ws = args.ws;
    C.WinT = (bf16_t*)(ws + WS_WINT); C.WoutT = (bf16_t*)(ws + WS_WOUT); C.XB = (bf16_t*)(ws + WS_XB); C.MIX = (bf16_t*)(ws + WS_MIX); C.PJ = (bf16_t*)(ws + WS_PJ);
    C.CMPK_P = (bf16_t*)(ws + WS_CMPK_P); C.CMPV_P = (bf16_t*)(ws + WS_CMPV_P); C.CMPK_S = (bf16_t*)(ws + WS_CMPK_S); C.CMPV_S = (bf16_t*)(ws + WS_CMPV_S);
    C.RS = (float*)(ws + WS_RS); C.BONUS = (float*)(ws + WS_BONUS); C.WduT = (bf16_t*)(ws + WS_WDUT); C.WauT = (bf16_t*)(ws + WS_WAUT); C.CHK = ws + WS_CHK; C.S0R = ws + WS_S0;
    C.RWkk = (float*)(ws + WS_RW); C.RWw = (float*)(ws + WS_RW + RW_STRIDE); C.RWb = (float*)(ws + WS_RW + 2 * RW_STRIDE);
    C.RWk = (float*)(ws + WS_RW + 3 * RW_STRIDE); C.RWr = (float*)(ws + WS_RW + 4 * RW_STRIDE); C.RWv = (float*)(ws + WS_RW + 5 * RW_STRIDE);
    C.tid = threadIdx.x; C.lane = C.tid & 63; C.wid = __builtin_amdgcn_readfirstlane(C.tid >> 6); C.bid = blockIdx.x; C.G = gridDim.x;
    C.gw = C.bid * 8 + C.wid; C.NGW = C.G * 8;

    volatile LAS unsigned* MISC = (volatile LAS unsigned*)(lds + MISC_OFF);
    if (C.tid < 64) MISC[C.tid] = 0u;
    __syncthreads();
    const int lo = args.ph_lo, hi = args.ph_hi;
    const bool one = (hi - lo) > 1;
    XcdBarrier bar; bar.bar = (unsigned*)(ws + WS_CTL) + 1024; bar.x = 0; bar.st = nullptr;
    if (one) bar = xcd_barrier_post((unsigned*)(ws + WS_CTL) + 1024, MISC + 8);
#ifndef PHMASK
#define PHMASK 0xff
#endif
#define REP(k) for (int rep_ = 0; rep_ < 1 + ((DUPMASK >> (k)) & 1); ++rep_)
#define IN(k) (((PHMASK >> (k)) & 1) && lo <= (k) && (k) < hi)
#define SEAM(k) do { if (IN(k) && IN((k) + 1 + ((k) == 2))) { xcd_barrier(bar); if ((DUPMASK >> 15) & 1) { xcd_barrier(bar); xcd_barrier(bar); } } } while (0)

    if (IN(0)) REP(0) { p0_prologue(C, lds); __syncthreads(); }
    SEAM(0);
    if (IN(1)) REP(1) {
        sample_gemm(C.XB + (size_t)MP * DM, C.WinT, NP / 32, C.bid, C.G, C.wid, C.lane, lds, [&](int row, int col, float a) {
            const int m = MP + row, t = row & 3, b = row >> 2; const float rs = C.RS[m];
            const float v = a * rs;
            C.PJ[(size_t)m * NP + col] = f2bf((col >= C_Q && col < C_GN) ? v * QSCALE : v);
            if (col >= C_KV) { const int c = col - C_KV; if (c < 512) C.out[O_KVS + (size_t)row * 512 + c] = v; else C.out[O_WINS + ((size_t)b * 512 + 508 + t) * 256 + (c - 512)] = v; }
            else if (col < ZW && t == 3) C.out[O_SHS + (size_t)b * ZW + col] = v;
        });
        pg8::Gemm g{C.XB, C.WinT, MP, NP, DM}; pg8::StaticOrder S; S.init(MP, NP, C.G, C.bid);
        pg8::EpiIn E{C.PJ, C.RS, C.out};
        pg8::gemm_phase<pg8::EpiIn, pg8::StaticOrder, true, true>(lds, g, S, E);
        __syncthreads();
    }
    SEAM(1);
    if (IN(2)) { p2_rwkv_chunks(C, lds);
#if (DUPMASK >> 8) & 1
        p2_rwkv_chunks(C, lds);
#endif
        p2_compress_prompt(C, lds, C.bid, C.G);
    }
    SEAM(2);
    if (IN(4)) { p4_attention(C, lds); }
    SEAM(4);
    if (IN(5)) { p5_sample_attention(C, lds); }
    SEAM(5);
    if (IN(6)) REP(5) {
        sample_gemm(C.MIX + (size_t)MP * DM, C.WoutT, DM / 32, C.bid, C.G, C.wid, C.lane, lds, [&](int row, int col, float a) {
            C.out[O_YS + (size_t)row * DM + col] = C.xs[(size_t)row * DM + col] + a;
        });
        pg8::Gemm g{C.MIX, C.WoutT, MP, DM, DM}; pg8::StaticOrder S; S.init(MP, DM, C.G, C.bid);
        pg8::EpiOut E{C.XB, (bf16_t*)(C.ws + WS_YB)};
        pg8::gemm_phase<pg8::EpiOut, pg8::StaticOrder, true, true>(lds, g, S, E);
        __syncthreads();
    }
    SEAM(6);
    if (IN(7)) { p6_final_norm(C); }
#undef IN
#undef SEAM
}

extern "C" void kernel_launch(void* const* d_in, const int* in_sizes, int n_in, void* d_out, int out_size, void* d_ws, size_t ws_size, hipStream_t stream) {
    static int grid = 0;
    if (grid == 0) {
        if (n_in != 23 || (size_t)out_size != O_END || ws_size < WS_END) { fprintf(stderr, "kernel_launch: unexpected shapes: n_in %d out %d ws %zu\n", n_in, out_size, ws_size); grid = -1; return; }
        int dev = 0, cus = 0, per_cu = 0;
        if (hipGetDevice(&dev) != hipSuccess || hipDeviceGetAttribute(&cus, hipDeviceAttributeMultiprocessorCount, dev) != hipSuccess) { grid = -1; return; }
        if (hipFuncSetAttribute((const void*)fwd, hipFuncAttributeMaxDynamicSharedMemorySize, LDS_BYTES) != hipSuccess) { fprintf(stderr, "kernel_launch: hipFuncSetAttribute failed\n"); grid = -1; return; }
        if (hipOccupancyMaxActiveBlocksPerMultiprocessor(&per_cu, (const void*)fwd, 512, LDS_BYTES) != hipSuccess || per_cu < 1) fprintf(stderr, "kernel_launch: occupancy query says %d\n", per_cu);
        (void)hipGetLastError();
        grid = cus;
    }
    if (grid < 0) return;
    (void)hipMemsetAsync((char*)d_ws + WS_CTL, 0, CTL_BYTES, stream);
    Args a{};
    for (int i = 0; i < 23; ++i) a.in[i] = d_in[i];
    a.out = (float*)d_out; a.ws = (unsigned char*)d_ws;
    constexpr int NL = MK_N_LAUNCHES;
    static_assert(NL == 1 || NL == N_PHASES, "MK_N_LAUNCHES is 1 or 8");
    for (int li = 0; li < NL; ++li) {
        a.ph_lo = (NL == 1) ? 0 : li; a.ph_hi = (NL == 1) ? N_PHASES : li + 1;
        hipLaunchKernelGGL(fwd, dim3(grid), dim3(512), LDS_BYTES, stream, a);
        const hipError_t le = hipPeekAtLastError();
        if (le != hipSuccess) { fprintf(stderr, "kernel_launch: launch %d failed: %s\n", li, hipGetErrorName(le)); break; }
    }
}
```

```cpp
#include <hip/hip_runtime.h>
#include <cstdint>
#include <cstdio>
#include <cmath>

#ifndef DUPMASK
#define DUPMASK 0
#endif
#ifndef MK_N_LAUNCHES
#define MK_N_LAUNCHES 1
#endif

constexpr int DM = 1024, BATCH = 16, SEQ = 2048, DECB = 32, DECT = 4, PAST = 16384;
constexpr int MP = BATCH * SEQ;
constexpr int MS = DECB * DECT;
constexpr int MTOT = MP + MS;
constexpr int MPAD = 33024;
constexpr int NPROJ = 3992, NP = 4096;
constexpr int ZW = 1664;
constexpr int C_R = 0, C_K = 512, C_V = 1024, C_WD = 1536, C_AD = 1600, C_GL = 1664, C_GR = 1792, C_Q = 2304, C_GN = 2816, C_KV = 3328;
constexpr float QSCALE = 0.125f * 1.4426950408889634f;
constexpr size_t O_YP = 0;
constexpr size_t O_YS = O_YP + (size_t)MP * DM;
constexpr size_t O_KVP = O_YS + (size_t)MS * DM;
constexpr size_t O_KVS = O_KVP + (size_t)MP * 512;
constexpr size_t O_WINP = O_KVS + (size_t)MS * 512;
constexpr size_t O_WINS = O_WINP + (size_t)BATCH * 512 * 256;
constexpr size_t O_WKVP = O_WINS + (size_t)DECB * 512 * 256;
constexpr size_t O_WKVS = O_WKVP + (size_t)BATCH * 8 * 64 * 64;
constexpr size_t O_SHP = O_WKVS + (size_t)DECB * 8 * 64 * 64;
constexpr size_t O_SHS = O_SHP + (size_t)BATCH * ZW;
constexpr size_t O_END = O_SHS + (size_t)DECB * ZW;
static_assert(O_END == 58472448, "output size");
constexpr size_t MiB = 1u << 20;
constexpr size_t WS_CTL = 0, CTL_BYTES = 65536;
constexpr size_t WS_WINT = 1 * MiB, WS_WOUT = 9 * MiB, WS_RS = 11 * MiB;
constexpr size_t WS_CMPK_P = 12 * MiB, WS_CMPV_P = 12 * MiB + 512 * 1024, WS_CMPK_S = 13 * MiB, WS_CMPV_S = 21 * MiB, WS_BONUS = 29 * MiB;
constexpr size_t WS_WDUT = 31 * MiB, WS_WAUT = 31 * MiB + 128 * 1024;
constexpr size_t WS_XB = 32 * MiB, WS_MIX = 98 * MiB, WS_PJ = 164 * MiB, WS_RW = 424 * MiB, RW_STRIDE = 1 * MiB, WS_CHK = 432 * MiB, CHK_BYTES = 32768, WS_S0 = 640 * MiB, WS_YB = 680 * MiB, WS_END = 750 * MiB;
constexpr int LDS_BYTES = 147456;
constexpr int MISC_OFF = LDS_BYTES - 256;

#define LAS __attribute__((address_space(3)))
typedef unsigned short bf16_t;
typedef unsigned u32x4 __attribute__((ext_vector_type(4)));
typedef unsigned u32x2 __attribute__((ext_vector_type(2)));
typedef float f32x4 __attribute__((ext_vector_type(4)));
typedef float f32x16 __attribute__((ext_vector_type(16)));
typedef short bf16x8 __attribute__((ext_vector_type(8)));
typedef short s16x4 __attribute__((ext_vector_type(4)));
typedef float f32x2_t __attribute__((ext_vector_type(2)));
typedef __bf16 bf16x2_t __attribute__((ext_vector_type(2)));

__device__ __forceinline__ unsigned cvtpk(float lo, float hi) { f32x2_t v = {lo, hi}; bf16x2_t b = __builtin_convertvector(v, bf16x2_t); return __builtin_bit_cast(unsigned, b); }
__device__ __forceinline__ float bf2f(unsigned short u) { return __uint_as_float(((unsigned)u) << 16); }
__device__ __forceinline__ float bflo(unsigned w) { return __uint_as_float(w << 16); }
__device__ __forceinline__ float bfhi(unsigned w) { return __uint_as_float(w & 0xffff0000u); }
__device__ __forceinline__ unsigned short f2bf(float f) { return (unsigned short)(cvtpk(f, 0.f) & 0xffffu); }
__device__ __forceinline__ float wave_sum(float v) {
#pragma unroll
    for (int o = 1; o < 64; o <<= 1) v += __shfl_xor(v, o);
    return v;
}
__device__ __forceinline__ float wave_max(float v) {
#pragma unroll
    for (int o = 1; o < 64; o <<= 1) v = fmaxf(v, __shfl_xor(v, o));
    return v;
}
__device__ __forceinline__ float dpp_f(float v, int) { return v; }
#define DPPF(v, ctrl) __builtin_bit_cast(float, __builtin_amdgcn_update_dpp(0, __builtin_bit_cast(int, (v)), (ctrl), 0xF, 0xF, true))
__device__ __forceinline__ float wave_sum_dpp(float v) {
    v += DPPF(v, 0xB1); v += DPPF(v, 0x4E); v += DPPF(v, 0x141); v += DPPF(v, 0x140);
    const int iv = __builtin_bit_cast(int, v);
    const float r0 = __builtin_bit_cast(float, __builtin_amdgcn_readlane(iv, 0)), r1 = __builtin_bit_cast(float, __builtin_amdgcn_readlane(iv, 16));
    const float r2 = __builtin_bit_cast(float, __builtin_amdgcn_readlane(iv, 32)), r3 = __builtin_bit_cast(float, __builtin_amdgcn_readlane(iv, 48));
    return (r0 + r1) + (r2 + r3);
}
__device__ __forceinline__ float wave_max_dpp(float v) {
    v = fmaxf(v, DPPF(v, 0xB1)); v = fmaxf(v, DPPF(v, 0x4E)); v = fmaxf(v, DPPF(v, 0x141)); v = fmaxf(v, DPPF(v, 0x140));
    const int iv = __builtin_bit_cast(int, v);
    const float r0 = __builtin_bit_cast(float, __builtin_amdgcn_readlane(iv, 0)), r1 = __builtin_bit_cast(float, __builtin_amdgcn_readlane(iv, 16));
    const float r2 = __builtin_bit_cast(float, __builtin_amdgcn_readlane(iv, 32)), r3 = __builtin_bit_cast(float, __builtin_amdgcn_readlane(iv, 48));
    return fmaxf(fmaxf(r0, r1), fmaxf(r2, r3));
}
#define LDS_BAR() do { asm volatile("s_waitcnt lgkmcnt(0)" ::: "memory"); __builtin_amdgcn_s_barrier(); asm volatile("" ::: "memory"); } while (0)
__device__ __forceinline__ float fexp(float x) { return __expf(x); }
__device__ __forceinline__ float fsigm(float x) { return __builtin_amdgcn_rcpf(1.f + __expf(-x)); }
__device__ __forceinline__ float fsilu(float x) { return x * __builtin_amdgcn_rcpf(1.f + __expf(-x)); }
__device__ __forceinline__ float ftanh(float x) { return 1.f - 2.f * __builtin_amdgcn_rcpf(1.f + __expf(2.f * x)); }
__device__ __forceinline__ float sigm(float x) { return 1.f / (1.f + expf(-x)); }
__device__ __forceinline__ float silu(float x) { return x / (1.f + expf(-x)); }
__device__ __forceinline__ void unpack8(const u32x4 w, float* f) {
    f[0] = bflo(w.x); f[1] = bfhi(w.x); f[2] = bflo(w.y); f[3] = bfhi(w.y); f[4] = bflo(w.z); f[5] = bfhi(w.z); f[6] = bflo(w.w); f[7] = bfhi(w.w);
}

namespace pg8 {
#define PG8_LAS __attribute__((address_space(3)))
typedef unsigned short bf16_t;
typedef short bf16x8 __attribute__((ext_vector_type(8)));
typedef float f32x4 __attribute__((ext_vector_type(4)));
typedef unsigned u32x4 __attribute__((ext_vector_type(4)));
constexpr int BM = 256, BK = 64, HALF = 128, HTB = HALF * BK * 2  , STAGE_BYTES = 8 * HTB, NXCD = 8, WGM = 8;

__host__ __device__ __forceinline__ int lds_byte(int r, int c) { const int st = (r >> 4) * 2 + (c >> 5), rr = r & 15, cc = c & 31, ob = rr * 64 + cc * 2; return st * 1024 + (ob ^ (((ob >> 9) & 1) << 5)); }
__host__ __device__ __forceinline__ void stage_rc(int b, int& R, int& C) { const int st = b / 1024, sb = b % 1024, swz = sb ^ (((sb >> 9) & 1) << 5); R = (st >> 1) * 16 + swz / 64; C = (st & 1) * 32 + (swz % 64) / 2; }
__host__ __device__ __forceinline__ int perm32(int rho) { const int n = rho >> 4, i = rho & 15; return 8 * (i >> 2) + 4 * n + (i & 3); }

struct Unit { int pm, pn; };
struct Gemm { const bf16_t* A; const bf16_t* Bt; int M, N, K; };

struct StaticOrder {
    int nM, nN, nwg, G, c;
    __host__ __device__ void init(int M, int N, int G_, int c_) { nM = M / BM; nN = N / BM; nwg = nM * nN; G = G_; c = c_; }
    __host__ __device__ bool next(int i, Unit& u) const {
        const long L = (long)i * G + c; if (L >= nwg) return false;
        int wgid = (int)L; { const int q = nwg / NXCD, r = nwg % NXCD, xcd = wgid % NXCD, off = wgid / NXCD; wgid = (xcd < r ? xcd * (q + 1) : r * (q + 1) + (xcd - r) * q) + off; }
        const int nig = WGM * nN, gid = wgid / nig, fm = gid * WGM, gsz = (nM - fm) < WGM ? (nM - fm) : WGM;
        u.pm = fm + ((wgid % nig) % gsz); u.pn = (wgid % nig) / gsz; return true;
    }
    __device__ __forceinline__ void a_ready(const Unit&) const {}
    __device__ __forceinline__ void done(const Unit&) const {}
};

struct EpiIn {
    static constexpr bool PERM = true, AFTER_DRAIN = false;
    bf16_t* PJ; const float* RS; float* out;
    __device__ __forceinline__ void operator()(const f32x4 (&acc)[2][2][4][2], const Unit& u, int wr, int wc, int fr, int fq) const {
        const int pn = u.pn;
        const float qs = (pn == 9 || pn == 10) ? QSCALE : 1.0f;
#pragma unroll
        for (int ai = 0; ai < 2; ++ai)
#pragma unroll
            for (int m = 0; m < 4; ++m) {
                const int row = u.pm * BM + ai * HALF + wr * 64 + m * 16 + fr;
                const float rs = 1.0f;
                const float rq = qs;
#pragma unroll
                for (int bj = 0; bj < 2; ++bj) {
                    const int col0 = pn * BM + bj * HALF + wc * 32 + 8 * fq;
                    const f32x4 a0 = acc[ai][bj][m][0], a1 = acc[ai][bj][m][1];
                    u32x4 w; w.x = cvtpk(a0[0] * rq, a0[1] * rq); w.y = cvtpk(a0[2] * rq, a0[3] * rq); w.z = cvtpk(a1[0] * rq, a1[1] * rq); w.w = cvtpk(a1[2] * rq, a1[3] * rq);
                    if (!(pn == 13)) *(u32x4*)(PJ + (size_t)row * NP + col0) = w;
                    if (row < MTOT) {
                        if (pn >= 13) {
                            const f32x4 v0 = a0 * rs, v1 = a1 * rs;
                            const int c = col0 - C_KV;
                            if (c < 512) { float* o = out + O_KVP + (size_t)row * 512 + c; *(f32x4*)o = v0; *(f32x4*)(o + 4) = v1; }
                            else {
                                const int cw = c - 512;
                                if (row < MP) { const int t = row & 2047, b = row >> 11; if (t >= 1536) { float* o = out + O_WINP + ((size_t)b * 512 + (t - 1536)) * 256 + cw; *(f32x4*)o = v0; *(f32x4*)(o + 4) = v1; } }
                                else { const int r2 = row - MP, t = r2 & 3, b = r2 >> 2; float* o = out + O_WINS + ((size_t)b * 512 + 508 + t) * 256 + cw; *(f32x4*)o = v0; *(f32x4*)(o + 4) = v1; }
                            }
                        } else if (pn <= 6 && col0 < ZW) {
                            if (row < MP) { if ((row & 2047) == 2047) { float* o = out + O_SHP + (size_t)(row >> 11) * ZW + col0; *(f32x4*)o = a0 * rs; *(f32x4*)(o + 4) = a1 * rs; } }
                            else { const int r2 = row - MP; if ((r2 & 3) == 3) { float* o = out + O_SHS + (size_t)(r2 >> 2) * ZW + col0; *(f32x4*)o = a0 * rs; *(f32x4*)(o + 4) = a1 * rs; } }
                        }
                    }
                }
            }
    }
};
struct EpiOut {
    static constexpr bool PERM = true, AFTER_DRAIN = false;
    const bf16_t* xb; bf16_t* yb; const float* rms;
    __device__ __forceinline__ void operator()(const f32x4 (&acc)[2][2][4][2], const Unit& u, int wr, int wc, int fr, int fq) const {
#pragma unroll
        for (int ai = 0; ai < 2; ++ai)
#pragma unroll
            for (int m = 0; m < 4; ++m) {
                const int row = u.pm * BM + ai * HALF + wr * 64 + m * 16 + fr;
                const bf16_t* xr = xb + (size_t)row * DM;
                const float rm = rms[row];
#pragma unroll
                for (int bj = 0; bj < 2; ++bj) {
                    const int col0 = u.pn * BM + bj * HALF + wc * 32 + 8 * fq;
                    const u32x4 xw = *(const u32x4*)(xr + col0);
                    const f32x4 x0 = (f32x4){bflo(xw.x), bfhi(xw.x), bflo(xw.y), bfhi(xw.y)} * rm + acc[ai][bj][m][0], x1 = (f32x4){bflo(xw.z), bfhi(xw.z), bflo(xw.w), bfhi(xw.w)} * rm + acc[ai][bj][m][1];
                    u32x4 w; w.x = cvtpk(x0[0], x0[1]); w.y = cvtpk(x0[2], x0[3]); w.z = cvtpk(x1[0], x1[1]); w.w = cvtpk(x1[2], x1[3]);
                    *(u32x4*)(yb + (size_t)row * DM + col0) = w;
                }
            }
    }
};
template <class Epi, class Sched, bool ALIGN_EPI = false, bool SP2 = false>
__device__ __forceinline__ void gemm_phase(PG8_LAS unsigned char* lds, const Gemm g, const Sched& S, const Epi& E) {
    const int tid = threadIdx.x, wid = __builtin_amdgcn_readfirstlane(tid >> 6), lane = tid & 63, wr = wid >> 2, wc = wid & 3, fr = lane & 15, fq = lane >> 4;
    const int K = g.K, nt = K / BK;
    unsigned voffA[2], voffB[2];
#pragma unroll
    for (int i = 0; i < 2; ++i) { int R, C; stage_rc(tid * 16 + i * 8192, R, C); const int Rb = Epi::PERM ? ((R & ~31) + perm32(R & 31)) : R;
        voffA[i] = (unsigned)(R * K + C) * 2u; voffB[i] = (unsigned)(Rb * K + C) * 2u; }
    const size_t kstep = (size_t)(BK * 2);
    const size_t hstep = (size_t)HALF * K * 2;
    const size_t tstep = 2 * hstep;
    const unsigned ldsw = (unsigned)wid * 1024u;
    const int aoff = lds_byte(wr * 64 + fr, fq * 8), boff = lds_byte(wc * 32 + fr, fq * 8);
#define PG8_SA(b, h) (((b) * 2 + (h)) * HTB)
#define PG8_SB(b, h) ((4 + (b) * 2 + (h)) * HTB)
#define PG8_STAGE(bufoff, gbase, voff) do { _Pragma("unroll") for (int _i = 0; _i < 2; ++_i) \
        __builtin_amdgcn_global_load_lds((const unsigned*)((const char*)(gbase) + (voff)[_i]), (PG8_LAS unsigned*)(lds + (bufoff) + ldsw + _i * 8192), 16, 0, 0); } while (0)
#define PG8_LDA(dst, b, h) do { _Pragma("unroll") for (int m = 0; m < 4; ++m) _Pragma("unroll") for (int k = 0; k < 2; ++k) dst[m][k] = *(const PG8_LAS bf16x8*)(lds + PG8_SA(b, h) + aoff + m * 2048 + k * 1024); } while (0)
#define PG8_LDB(dst, b, h) do { _Pragma("unroll") for (int n = 0; n < 2; ++n) _Pragma("unroll") for (int k = 0; k < 2; ++k) dst[n][k] = *(const PG8_LAS bf16x8*)(lds + PG8_SB(b, h) + boff + n * 2048 + k * 1024); } while (0)
#define PG8_MMA(ai, bj, At, Bt) do { __builtin_amdgcn_s_setprio(1); _Pragma("unroll") for (int m = 0; m < 4; ++m) _Pragma("unroll") for (int n = 0; n < 2; ++n) _Pragma("unroll") for (int k = 0; k < 2; ++k) \
        acc[ai][bj][m][n] = __builtin_amdgcn_mfma_f32_16x16x32_bf16(Bt[n][k], At[m][k], acc[ai][bj][m][n], 0, 0, 0); __builtin_amdgcn_s_setprio(0); } while (0)
#define PG8_WAIT_V(n) asm volatile("s_waitcnt vmcnt(" #n ")" ::: "memory")
#define PG8_WAIT_L(n) asm volatile("s_waitcnt lgkmcnt(" #n ")" ::: "memory")
#define PG8_BAR __builtin_amdgcn_s_barrier()
#define PG8_SCHED __builtin_amdgcn_sched_barrier(0)
    Unit cur, nxt; int ui = 0;
    if (!S.next(0, cur)) return;
    f32x4 acc[2][2][4][2];
#pragma unroll
    for (int a = 0; a < 2; ++a)
#pragma unroll
        for (int b = 0; b < 2; ++b)
#pragma unroll
            for (int m = 0; m < 4; ++m)
#pragma unroll
                for (int n = 0; n < 2; ++n) acc[a][b][m][n] = (f32x4){0.f, 0.f, 0.f, 0.f};
    bf16x8 At[4][2], B0[2][2], B1[2][2];
    const char* cA = (const char*)g.A + (size_t)cur.pm * tstep; const char* cB = (const char*)g.Bt + (size_t)cur.pn * tstep;
    S.a_ready(cur);
    if constexpr (SP2) {
        PG8_STAGE(PG8_SB(0, 0), cB, voffB); PG8_STAGE(PG8_SB(0, 1), cB + hstep, voffB); PG8_STAGE(PG8_SA(0, 0), cA, voffA); PG8_STAGE(PG8_SA(0, 1), cA + hstep, voffA);
        if (wr == 1) PG8_BAR;
        PG8_WAIT_V(2); PG8_BAR;
        PG8_STAGE(PG8_SB(1, 0), cB + kstep, voffB); PG8_STAGE(PG8_SA(1, 0), cA + kstep, voffA); PG8_STAGE(PG8_SB(1, 1), cB + hstep + kstep, voffB);
        PG8_WAIT_V(6); PG8_BAR;
    } else {
        PG8_STAGE(PG8_SB(0, 0), cB, voffB); PG8_STAGE(PG8_SA(0, 0), cA, voffA); PG8_STAGE(PG8_SB(0, 1), cB + hstep, voffB); PG8_STAGE(PG8_SA(0, 1), cA + hstep, voffA);
        if (wr == 1) PG8_BAR;
        PG8_WAIT_V(4); PG8_BAR;
        PG8_STAGE(PG8_SB(1, 0), cB + kstep, voffB); PG8_STAGE(PG8_SA(1, 0), cA + kstep, voffA); PG8_STAGE(PG8_SB(1, 1), cB + hstep + kstep, voffB);
        PG8_WAIT_V(6); PG8_BAR;
    }
    for (;;) {
        const bool has_next = S.next(ui + 1, nxt);
        const char* nA = has_next ? (const char*)g.A + (size_t)nxt.pm * tstep : cA; const char* nB = has_next ? (const char*)g.Bt + (size_t)nxt.pn * tstep : cB;
        for (int t = 0; t < nt; t += 2) {
            const bool last = (t == nt - 2);
            const char* a1 = cA + (size_t)(t + 1) * kstep;
            const char* a2 = last ? nA : cA + (size_t)(t + 2) * kstep; const char* b2 = last ? nB : cB + (size_t)(t + 2) * kstep;
            const char* a3 = a2 + kstep; const char* b3 = b2 + kstep;
            if (last && has_next) S.a_ready(nxt);
            if constexpr (SP2) {
            PG8_LDB(B0, 0, 0); PG8_LDB(B1, 0, 1); PG8_SCHED; PG8_LDA(At, 0, 0); PG8_STAGE(PG8_SA(1, 1), a1 + hstep, voffA);
            PG8_WAIT_V(8); PG8_WAIT_L(0); PG8_BAR; PG8_MMA(0, 0, At, B0); PG8_MMA(0, 1, At, B1); PG8_BAR; PG8_SCHED;
            PG8_LDA(At, 0, 1); PG8_STAGE(PG8_SB(0, 0), b2, voffB); PG8_STAGE(PG8_SB(0, 1), b2 + hstep, voffB); PG8_STAGE(PG8_SA(0, 0), a2, voffA);
            PG8_WAIT_V(8); PG8_WAIT_L(0); PG8_BAR; PG8_MMA(1, 0, At, B0); PG8_MMA(1, 1, At, B1); PG8_BAR; PG8_SCHED;
            PG8_LDB(B0, 1, 0); PG8_LDB(B1, 1, 1); PG8_SCHED; PG8_LDA(At, 1, 0); PG8_STAGE(PG8_SA(0, 1), a2 + hstep, voffA);
            PG8_WAIT_V(8); PG8_WAIT_L(0); PG8_BAR; PG8_MMA(0, 0, At, B0); PG8_MMA(0, 1, At, B1); PG8_BAR; PG8_SCHED;
            PG8_LDA(At, 1, 1); PG8_STAGE(PG8_SB(1, 0), b3, voffB); PG8_STAGE(PG8_SB(1, 1), b3 + hstep, voffB); PG8_STAGE(PG8_SA(1, 0), a3, voffA);
            PG8_WAIT_V(8); PG8_WAIT_L(0); PG8_BAR; PG8_MMA(1, 0, At, B0); PG8_MMA(1, 1, At, B1); PG8_BAR; PG8_SCHED;
            } else {
            PG8_LDB(B0, 0, 0); PG8_SCHED; PG8_LDA(At, 0, 0); PG8_STAGE(PG8_SA(1, 1), a1 + hstep, voffA);
            PG8_WAIT_L(8); PG8_BAR; PG8_WAIT_L(0); PG8_MMA(0, 0, At, B0); PG8_BAR; PG8_SCHED;
            PG8_LDB(B1, 0, 1); PG8_STAGE(PG8_SB(0, 0), b2, voffB);
            PG8_BAR; PG8_WAIT_L(0); PG8_MMA(0, 1, At, B1); PG8_BAR;
            PG8_LDA(At, 0, 1); PG8_STAGE(PG8_SA(0, 0), a2, voffA);
            PG8_BAR; PG8_WAIT_L(0); PG8_MMA(1, 0, At, B0); PG8_BAR; PG8_SCHED;
            PG8_STAGE(PG8_SB(0, 1), b2 + hstep, voffB);
            PG8_WAIT_V(6); PG8_BAR; PG8_MMA(1, 1, At, B1); PG8_BAR;
            PG8_LDB(B0, 1, 0); PG8_SCHED; PG8_LDA(At, 1, 0); PG8_STAGE(PG8_SA(0, 1), a2 + hstep, voffA);
            PG8_WAIT_L(8); PG8_BAR; PG8_WAIT_L(0); PG8_MMA(0, 0, At, B0); PG8_BAR; PG8_SCHED;
            PG8_LDB(B1, 1, 1); PG8_STAGE(PG8_SB(1, 0), b3, voffB);
            PG8_BAR; PG8_WAIT_L(0); PG8_MMA(0, 1, At, B1); PG8_BAR;
            PG8_LDA(At, 1, 1); PG8_STAGE(PG8_SA(1, 0), a3, voffA);
            PG8_BAR; PG8_WAIT_L(0); PG8_MMA(1, 0, At, B0); PG8_BAR; PG8_SCHED;
            PG8_STAGE(PG8_SB(1, 1), b3 + hstep, voffB);
            PG8_WAIT_V(6); PG8_BAR; PG8_MMA(1, 1, At, B1); PG8_BAR;
            }
        }
        if constexpr (ALIGN_EPI) { if (wr == 0) PG8_BAR; }
        if constexpr (!Epi::AFTER_DRAIN) { E(acc, cur, wr, wc, fr, fq); S.done(cur); }
        if (!has_next) break;
#pragma unroll
        for (int a = 0; a < 2; ++a)
#pragma unroll
            for (int b = 0; b < 2; ++b)
#pragma unroll
                for (int m = 0; m < 4; ++m)
#pragma unroll
                    for (int n = 0; n < 2; ++n) acc[a][b][m][n] = (f32x4){0.f, 0.f, 0.f, 0.f};
        cur = nxt; cA = nA; cB = nB; ++ui;
        if constexpr (ALIGN_EPI) { if (wr == 1) PG8_BAR; }
    }
    PG8_WAIT_V(0);
    if constexpr (!ALIGN_EPI) { if (wr == 0) PG8_BAR; }
    PG8_BAR;
    if constexpr (Epi::AFTER_DRAIN) { E.fused(acc, cur, wr, wc, fr, fq, lds, wid, lane); S.done(cur); }
#undef PG8_SA
#undef PG8_SB
#undef PG8_STAGE
#undef PG8_LDA
#undef PG8_LDB
#undef PG8_MMA
#undef PG8_WAIT_V
#undef PG8_WAIT_L
#undef PG8_BAR
#undef PG8_SCHED
}
}

template <class F>
__device__ __forceinline__ void sample_gemm(const unsigned short* A, const unsigned short* Bt, int ncb, int first, int stride, int wid, int lane, __attribute__((address_space(3))) unsigned char* lds, const F& fn) {
    typedef short bf16x8_t __attribute__((ext_vector_type(8)));
    typedef float f32x16_t __attribute__((ext_vector_type(16)));
    typedef float f32x4_t __attribute__((ext_vector_type(4)));
    const int r32 = lane & 31, hi = lane >> 5, rt = wid & 3, kh = wid >> 2;
    for (int cb = first; cb < ncb; cb += stride) {
        f32x16_t acc = (f32x16_t){};
        const unsigned short* ap = A + (size_t)(32 * rt + r32) * 1024 + 512 * kh + 8 * hi;
        const unsigned short* bp = Bt + (size_t)(cb * 32 + r32) * 1024 + 512 * kh + 8 * hi;
#pragma unroll 16
        for (int ks = 0; ks < 32; ++ks) acc = __builtin_amdgcn_mfma_f32_32x32x16_bf16(*(const bf16x8_t*)(ap + 16 * ks), *(const bf16x8_t*)(bp + 16 * ks), acc, 0, 0, 0);
        __attribute__((address_space(3))) f32x4_t* ex = (__attribute__((address_space(3))) f32x4_t*)lds + (rt * 64 + lane) * 4;
        __syncthreads();
        if (kh == 1) {
#pragma unroll
            for (int q = 0; q < 4; ++q) ex[q] = (f32x4_t){acc[4 * q], acc[4 * q + 1], acc[4 * q + 2], acc[4 * q + 3]};
        }
        __syncthreads();
        if (kh == 0) {
#pragma unroll
            for (int q = 0; q < 4; ++q) { const f32x4_t o = ex[q]; acc[4 * q] += o.x; acc[4 * q + 1] += o.y; acc[4 * q + 2] += o.z; acc[4 * q + 3] += o.w; }
#pragma unroll
            for (int r = 0; r < 16; ++r) fn(32 * rt + (r & 3) + 8 * (r >> 2) + 4 * hi, cb * 32 + r32, acc[r]);
        }
    }
    __syncthreads();
}

#define XB_TMO      128
#define XB_XCNT(j)  (256  + 64 * (j))
#define XB_XSUB(j)  (1280 + 64 * (j))
#define XB_XGEN(j)  (2304 + 64 * (j))
#define XB_TOP      3328
#define XB_TOPGEN   3392
#define XCD_BAR_WORDS 3456
#define XB_SPIN_CAP (1u << 18)

__device__ __forceinline__ unsigned xb_ld(unsigned* p)              { return __hip_atomic_load(p, __ATOMIC_RELAXED, __HIP_MEMORY_SCOPE_AGENT); }
__device__ __forceinline__ unsigned xb_add(unsigned* p, unsigned v) { return __hip_atomic_fetch_add(p, v, __ATOMIC_RELAXED, __HIP_MEMORY_SCOPE_AGENT); }
__device__ __forceinline__ unsigned xb_xcc_id() { return (unsigned)__builtin_amdgcn_s_getreg((3 << 11) | 20) & 0xFu; }
#define XB_SPIN(cond, bar) do { unsigned _sp = 0; while (cond) { __builtin_amdgcn_s_sleep(1); \
    if ((++_sp & 255u) == 0u) { if (xb_ld(&(bar)[XB_TMO])) break; if (_sp > XB_SPIN_CAP) { atomicAdd(&(bar)[XB_TMO], 1u); break; } } } } while (0)

struct XcdBarrier {
    unsigned* bar; unsigned x;
    volatile LAS unsigned* st;
};

__device__ __forceinline__ XcdBarrier xcd_barrier_post(unsigned* bar, volatile LAS unsigned* st) {
    XcdBarrier b; b.bar = bar; b.x = xb_xcc_id(); b.st = st;
    if (threadIdx.x == 0) (void)xb_add(&bar[XB_XCNT(b.x)], 1u);
    return b;
}
__device__ __forceinline__ void xcd_barrier_complete(unsigned* bar, unsigned x, unsigned& nloc, unsigned& nx) {
    const unsigned G = gridDim.x * gridDim.y * gridDim.z;
    unsigned sum, cnt, mine, sp = 0u;
    for (;;) {
        sum = 0u; cnt = 0u; mine = 0u;
#pragma unroll
        for (unsigned j = 0; j < 16; ++j) { const unsigned c = xb_ld(&bar[XB_XCNT(j)]); sum += c; cnt += (c > 0u) ? 1u : 0u; mine = (j == x) ? c : mine; }
        if (sum == G) break;
        __builtin_amdgcn_s_sleep(1);
        if ((++sp & 255u) == 0u) { if (xb_ld(&bar[XB_TMO])) break; if (sp > XB_SPIN_CAP) { atomicAdd(&bar[XB_TMO], 1u); break; } }
    }
    nloc = mine > 0u ? mine : 1u; nx = cnt > 0u ? cnt : 1u;
}

__device__ __forceinline__ void xcd_barrier(const XcdBarrier& b) {
    asm volatile("s_waitcnt vmcnt(0)" ::: "memory");
    __syncthreads();
    if (threadIdx.x == 0) {
        unsigned* bar = b.bar;
        __builtin_amdgcn_s_waitcnt(0);
        unsigned nloc = b.st[0], nx = b.st[1];
        if (nloc == 0u) { xcd_barrier_complete(bar, b.x, nloc, nx); b.st[0] = nloc; b.st[1] = nx; }
        const unsigned old = xb_add(&bar[XB_XSUB(b.x)], 1u);
        const unsigned gen = old / nloc;
        if (old + 1u == (gen + 1u) * nloc) {
            __builtin_amdgcn_fence(__ATOMIC_RELEASE, "agent");
            asm volatile("s_waitcnt vmcnt(0)" ::: "memory");
            const unsigned og = xb_add(&bar[XB_TOP], 1u);
            const unsigned tg = og / nx;
            if (og + 1u == (tg + 1u) * nx) xb_add(&bar[XB_TOPGEN], 1u);
            else XB_SPIN(xb_ld(&bar[XB_TOPGEN]) == tg, bar);
            __builtin_amdgcn_fence(__ATOMIC_ACQUIRE, "agent");
            xb_add(&bar[XB_XGEN(b.x)], 1u);
            asm volatile("s_waitcnt vmcnt(0)" ::: "memory");
        } else {
            XB_SPIN(xb_ld(&bar[XB_XGEN(b.x)]) == gen, bar);
            __builtin_amdgcn_fence(__ATOMIC_ACQUIRE, "agent");
            asm volatile("s_waitcnt vmcnt(0)" ::: "memory");
        }
    }
    __syncthreads();
}

struct Ctx {
    const float *xp, *xs, *cache, *win, *swkv, *sshift; const int* pt;
    const float *norm_g, *w_in, *mu, *w0, *wdu, *a0, *wau, *k_k, *k_a, *r_k, *gn_w, *gn_b, *wpos, *wmix, *w_out, *final_g;
    float* out; unsigned char* ws;
    bf16_t *WinT, *WoutT, *XB, *MIX, *PJ, *CMPK_P, *CMPV_P, *CMPK_S, *CMPV_S, *WduT, *WauT;
    unsigned char* CHK; unsigned char* S0R;
    float *RS, *BONUS, *RWkk, *RWw, *RWb, *RWk, *RWr, *RWv;
    int tid, lane, wid, bid, G, gw, NGW;
};

__device__ __forceinline__ int orig_col(int n) {
    if (n < 1664) return n;
    if (n < 1688) return 3968 + (n - 1664);
    if (n < 1792) return -1;
    if (n < 2304) return 1664 + (n - 1792);
    if (n < 2816) return 2176 + (n - 2304);
    if (n < 3328) return 2688 + (n - 2816);
    return 3200 + (n - 3328);
}
__device__ __forceinline__ void transpose_item(const float* W, int ldw, const float* gscale, bool permute, bf16_t* WT, int K, LAS float* scr, int item, int nblk, int lane) {
    const int kb = item / nblk, nb = item % nblk, k0 = 64 * kb, n0 = 32 * nb;
    const int n = n0 + (lane & 31); const int oc = permute ? orig_col(n) : n;
#pragma unroll 8
    for (int i = 0; i < 32; ++i) {
        const int kk = 2 * i + (lane >> 5); float v = 0.f;
        if (oc >= 0) { v = W[(size_t)(k0 + kk) * ldw + oc]; if (gscale) v *= gscale[k0 + kk]; }
        scr[kk * 33 + (lane & 31)] = v;
    }
    asm volatile("s_waitcnt lgkmcnt(0)" ::: "memory");
    const int c = lane & 7;
#pragma unroll
    for (int j = 0; j < 4; ++j) {
        const int nn = (lane >> 3) + 8 * j; const LAS float* s = scr + (8 * c) * 33 + nn;
        u32x4 o; o.x = cvtpk(s[0 * 33], s[1 * 33]); o.y = cvtpk(s[2 * 33], s[3 * 33]); o.z = cvtpk(s[4 * 33], s[5 * 33]); o.w = cvtpk(s[6 * 33], s[7 * 33]);
        *(u32x4*)(WT + (size_t)(n0 + nn) * K + k0 + 8 * c) = o;
    }
    asm volatile("s_waitcnt lgkmcnt(0)" ::: "memory");
}

struct RowsPrompt { const float* kvp;
    __device__ __forceinline__ void prep(int, int, int (&)[5]) const {}
    __device__ __forceinline__ const float* at(int b, int pos, int, const int (&)[5]) const { return kvp + ((size_t)(b * 2048 + pos)) * 512; } };
struct RowsSample { const float* cache; const int* pt;
    __device__ __forceinline__ void prep(int b, int pos0, int (&pg)[5]) const {
#pragma unroll
        for (int k = 0; k < 5; ++k) { const int pi = (pos0 >> 7) + k; pg[k] = pt[b * 128 + (pi < 127 ? pi : 127)]; }
    }
    __device__ __forceinline__ const float* at(int b, int pos, int pos0, const int (&pg)[5]) const {
        const int k = (pos >> 7) - (pos0 >> 7);
        const int p = (k == 0) ? pg[0] : (k == 1) ? pg[1] : (k == 2) ? pg[2] : (k == 3) ? pg[3] : pg[4];
        return cache + ((size_t)p * 128 + (pos & 127)) * 512; } };

constexpr int CMP_WP = 0, CMP_WT = 16384, CMP_X = 34816, CMP_PA = 53248, CMP_PB = 87040, CMP_END = 120832, CMP_LD = 72;
__device__ __forceinline__ void load_cmp_consts(const Ctx& C, LAS unsigned char* lds) {
    LAS float* wp = (LAS float*)(lds + CMP_WP); LAS bf16_t* wt = (LAS bf16_t*)(lds + CMP_WT);
    for (int i = C.tid; i < 2 * 32 * 64; i += 512) wp[i] = C.wpos[i];
    for (int i = C.tid; i < 2 * 64 * 64; i += 512) { const int e = i >> 12, d = (i >> 6) & 63, f = i & 63; wt[(e * 64 + f) * CMP_LD + d] = f2bf(C.wmix[i]); }
    LDS_BAR();
}
struct CmpW { f32x4 w1[16], w2[16]; };
__device__ __forceinline__ void load_cmp_w(const Ctx& C, CmpW& W) {
    const int e4 = C.lane >> 5, d0 = (4 * C.lane) & 63;
#pragma unroll
    for (int p = 0; p < 16; ++p) { W.w1[p] = *(const f32x4*)(C.wpos + (e4 * 32 + p) * 64 + d0); W.w2[p] = *(const f32x4*)(C.wpos + (e4 * 32 + 16 + p) * 64 + d0); }
}
template <class Rows>
__device__ __forceinline__ void compress_item(const Rows& R, int b, int j0, int nj, LAS unsigned char* lds, bf16_t* outK, bf16_t* outV, int jpitch, int tid, int lane, int wid, const CmpW& W) {
    LAS float* PA = (LAS float*)(lds + CMP_PA); LAS float* PB = (LAS float*)(lds + CMP_PB);
    {
        int pgs[5]; R.prep(b, 16 * j0, pgs);
        const LAS float* wl = (const LAS float*)(lds + CMP_WP) + (lane >> 5) * 32 * 64 + ((4 * lane) & 63);
        auto ld = [&](f32x4 (&v)[16], int c) {
            const float* base = R.at(b, 16 * (j0 + c), 16 * j0, pgs) + 4 * lane;
#pragma unroll
            for (int p = 0; p < 16; ++p) v[p] = __builtin_nontemporal_load((const f32x4*)(base + (size_t)p * 512));
        };
        auto pool = [&](const f32x4 (&v)[16], int c) {
            f32x4 a = (f32x4){0.f, 0.f, 0.f, 0.f}, bb = a;
#pragma unroll
            for (int p = 0; p < 16; ++p) { a += v[p] * *(const LAS f32x4*)(wl + p * 64); bb += v[p] * *(const LAS f32x4*)(wl + (16 + p) * 64); }
            *(LAS f32x4*)(PA + c * 256 + 4 * lane) = a; *(LAS f32x4*)(PB + c * 256 + 4 * lane) = bb;
        };
        int cl = wid;
        f32x4 va[16], vb[16];
        if (cl <= nj) ld(va, cl);
#pragma unroll 1
        while (cl <= nj) {
            if (cl + 8 <= nj) ld(vb, cl + 8);
            pool(va, cl);
            if (cl + 8 > nj) break;
            if (cl + 16 <= nj) ld(va, cl + 16);
            pool(vb, cl + 8);
            cl += 16;
        }
    }
    LDS_BAR();
    {
        LAS bf16_t* X = (LAS bf16_t*)(lds + CMP_X);
#pragma unroll
        for (int k = 0; k < 4; ++k) {
            const int i = tid + 512 * k, jj = i >> 6, c4 = i & 63, col = 4 * c4, e = col >> 7, kvh = (col >> 6) & 1, d = col & 63;
            f32x4 p = (f32x4){0.f, 0.f, 0.f, 0.f};
            if (jj < nj) p = *(const LAS f32x4*)(PA + jj * 256 + col) + *(const LAS f32x4*)(PB + (jj + 1) * 256 + col);
            u32x2 w; w.x = cvtpk(p.x, p.y); w.y = cvtpk(p.z, p.w);
            *(LAS u32x2*)(X + (e * 64 + 2 * jj + kvh) * CMP_LD + d) = w;
        }
    }
    LDS_BAR();
    {
        const int r32 = lane & 31, hi = lane >> 5, e = wid >> 2, tm = (wid >> 1) & 1, tn = wid & 1;
        const LAS char* A = (const LAS char*)(lds + CMP_X) + e * 64 * CMP_LD * 2; const LAS char* Bt = (const LAS char*)(lds + CMP_WT) + e * 64 * CMP_LD * 2;
        f32x16 acc = (f32x16){};
#pragma unroll
        for (int ks = 0; ks < 4; ++ks) {
            const bf16x8 af = *(const LAS bf16x8*)(A + ((32 * tm + r32) * CMP_LD + 16 * ks + 8 * hi) * 2), bf = *(const LAS bf16x8*)(Bt + ((32 * tn + r32) * CMP_LD + 16 * ks + 8 * hi) * 2);
            acc = __builtin_amdgcn_mfma_f32_32x32x16_bf16(af, bf, acc, 0, 0, 0);
        }
        bf16_t* ob = (e == 0 ? outK : outV);
#pragma unroll
        for (int r = 0; r < 16; ++r) {
            const int row = 32 * tm + (r & 3) + 8 * (r >> 2) + 4 * hi, jj = row >> 1, kvh = row & 1;
            if (jj < nj) ob[((size_t)(b * 2 + kvh) * jpitch + j0 + jj) * 64 + 32 * tn + r32] = f2bf(acc[r]);
        }
    }
    LDS_BAR();
}

__device__ __forceinline__ void p0_prologue(const Ctx& C, LAS unsigned char* lds) {
    {
        LAS float* scr = (LAS float*)(lds + C.wid * 16384);
        constexpr int I_IN = (DM / 64) * (NP / 32), I_OUT = (DM / 64) * (DM / 32);
        for (int it = C.gw; it < I_IN + I_OUT; it += C.NGW) {
            if (it < I_IN) transpose_item(C.w_in, NPROJ, C.norm_g, true, C.WinT, DM, scr, it, NP / 32, C.lane);
            else transpose_item(C.w_out, DM, nullptr, false, C.WoutT, DM, scr, it - I_IN, DM / 32, C.lane);
        }
    }
    for (int i = C.bid * 512 + C.tid; i < 2 * 512 * 64; i += C.G * 512) {
        const int which = i >> 15, r = i & 32767, n = r >> 6, c = r & 63;
        const float v = (which ? C.wau : C.wdu)[c * 512 + n];
        (which ? C.WauT : C.WduT)[n * 64 + c] = f2bf(v);
    }
    for (int m4 = C.gw * 4; m4 < MTOT; m4 += C.NGW * 4) {
        f32x4 v[4][4]; float ss[4];
#pragma unroll
        for (int q = 0; q < 4; ++q) {
            const int m = m4 + q;
            const float* xr = m < MP ? C.xp + (size_t)m * DM : C.xs + (size_t)(m - MP) * DM;
#pragma unroll
            for (int j = 0; j < 4; ++j) v[q][j] = *(const f32x4*)(xr + 4 * (C.lane + 64 * j));
        }
#pragma unroll
        for (int q = 0; q < 4; ++q) {
            float a = 0.f;
#pragma unroll
            for (int j = 0; j < 4; ++j) a += (v[q][j].x * v[q][j].x + v[q][j].y * v[q][j].y) + (v[q][j].z * v[q][j].z + v[q][j].w * v[q][j].w);
            ss[q] = wave_sum_dpp(a);
        }
#pragma unroll
        for (int q = 0; q < 4; ++q) {
            const int m = m4 + q;
            const float rms = sqrtf(ss[q] * (1.0f / DM) + 1e-6f), rs = 1.0f / rms;
            if (C.lane == 0) C.RS[m] = rms;
#pragma unroll
            for (int j = 0; j < 4; ++j) { const f32x4 t = v[q][j] * rs; u32x2 o; o.x = cvtpk(t.x, t.y); o.y = cvtpk(t.z, t.w); *(u32x2*)(C.XB + (size_t)m * DM + 4 * (C.lane + 64 * j)) = o; }
        }
    }
    for (int i = C.bid * 512 + C.tid; i < DECB * 508 * 64; i += C.G * 512) {
        const int b = i / (508 * 64), rem = i % (508 * 64), r = rem >> 6, c4 = rem & 63;
        *(f32x4*)(C.out + O_WINS + ((size_t)b * 512 + r) * 256 + c4 * 4) = *(const f32x4*)(C.win + ((size_t)b * 512 + r + 4) * 256 + c4 * 4);
    }
}

__device__ __forceinline__ float zshift(const Ctx& C, int m, int col) {
    const float z = bf2f(C.PJ[(size_t)m * NP + col]);
    float zp;
    if (m < MP) { zp = (m & 2047) ? bf2f(C.PJ[(size_t)(m - 1) * NP + col]) : 0.f; }
    else { const int r = m - MP; zp = (r & 3) ? bf2f(C.PJ[(size_t)(m - 1) * NP + col]) : C.sshift[(size_t)(r >> 2) * ZW + col]; }
    return z + (zp - z) * C.mu[col];
}
__device__ __forceinline__ void p2_compress_prompt(const Ctx& C, LAS unsigned char* lds, int first, int stride) {
    __syncthreads();
    load_cmp_consts(C, lds);
    CmpW W; load_cmp_w(C, W);
    RowsPrompt R{C.out + O_KVP};
    for (int it = first; it < BATCH * 16; it += stride) {
        const int b = it >> 4, j0 = (it & 15) * 8; const int nj = (127 - j0) < 8 ? (127 - j0) : 8;
        compress_item(R, b, j0, nj, lds, C.CMPK_P, C.CMPV_P, 128, C.tid, C.lane, C.wid, W);
    }
    __builtin_amdgcn_s_waitcnt(0x0F70);
    for (int i = first * 512 + C.tid; i < BATCH * 2 * 64; i += stride * 512) { const int bk = i >> 6, d = i & 63; C.CMPK_P[((size_t)bk * 128 + 127) * 64 + d] = 0; C.CMPV_P[((size_t)bk * 128 + 127) * 64 + d] = 0; }
    __syncthreads();
}

__device__ __forceinline__ void rwkv_sample_unit(const Ctx& C, int b, int h, LAS float* sl  ) {
    const int lane = C.lane, n = h * 64 + lane, msb = MP + b * DECT;
    LAS float* zs = sl + 320;
    LAS float* lo = sl + 1600;
    {
        const int cols[5] = {C_R + n, C_K + n, C_V + n, C_WD + lane, C_AD + lane};
#pragma unroll
        for (int sg = 0; sg < 5; ++sg) {
            const float mu = C.mu[cols[sg]];
            float prev = C.sshift[(size_t)b * ZW + cols[sg]];
#pragma unroll
            for (int t = 0; t < 4; ++t) {
                const float z = bf2f(C.PJ[(size_t)(msb + t) * NP + cols[sg]]);
                const float v = z + (prev - z) * mu;
                zs[(t * 5 + sg) * 64 + lane] = (sg == 3) ? tanhf(v) : v;
                prev = z;
            }
        }
    }
    asm volatile("s_waitcnt lgkmcnt(0)" ::: "memory");
    {
        float wl[4], al[4];
        const float w0v = C.w0[n], a0v = C.a0[n];
#pragma unroll
        for (int t = 0; t < 4; ++t) { wl[t] = w0v; al[t] = a0v; }
#pragma unroll 4
        for (int c = 0; c < 64; ++c) {
            const float wu = C.wdu[c * 512 + n], au = C.wau[c * 512 + n];
#pragma unroll
            for (int t = 0; t < 4; ++t) { wl[t] += zs[(t * 5 + 3) * 64 + c] * wu; al[t] += zs[(t * 5 + 4) * 64 + c] * au; }
        }
#pragma unroll
        for (int t = 0; t < 4; ++t) { lo[t * 128 + lane] = wl[t]; lo[t * 128 + 64 + lane] = al[t]; }
    }
    asm volatile("s_waitcnt lgkmcnt(0)" ::: "memory");
    float S[64];
    {
        const float* sp = C.swkv + ((size_t)(b * 8 + h) * 64 + lane) * 64;
#pragma unroll
        for (int j = 0; j < 64; j += 4) { const f32x4 q = *(const f32x4*)(sp + j); S[j] = q.x; S[j + 1] = q.y; S[j + 2] = q.z; S[j + 3] = q.w; }
    }
    const float gw_ = C.gn_w[n], gb_ = C.gn_b[n], kkn = C.k_k[n], kan = C.k_a[n], rkn = C.r_k[n];
#pragma unroll 1
    for (int t = 0; t < 4; ++t) {
        const int m = msb + t;
        const float r = zs[(t * 5 + 0) * 64 + lane], k = zs[(t * 5 + 1) * 64 + lane], vi = zs[(t * 5 + 2) * 64 + lane];
        const float x = -lo[t * 128 + lane];
        const float sp_ = fmaxf(x, 0.f) + log1pf(expf(-fabsf(x)));
        const float dec = expf(-expf(-sp_ - 0.5f));
        const float a = sigm(lo[t * 128 + 64 + lane]);
        float kk = k * kkn;
        const float ss = wave_sum(kk * kk);
        kk *= 1.0f / sqrtf(fmaxf(ss, 1e-24f));
        const float km = k * (1.0f + (a - 1.0f) * kan);
        const float bon = wave_sum(r * km * rkn);
        sl[0 * 64 + lane] = kk; sl[1 * 64 + lane] = dec; sl[2 * 64 + lane] = kk * a; sl[3 * 64 + lane] = km; sl[4 * 64 + lane] = r;
        asm volatile("s_waitcnt lgkmcnt(0)" ::: "memory");
        const LAS f32x4* pk = (const LAS f32x4*)(sl); const LAS f32x4* pw = (const LAS f32x4*)(sl + 64); const LAS f32x4* pb = (const LAS f32x4*)(sl + 128);
        const LAS f32x4* pm = (const LAS f32x4*)(sl + 192); const LAS f32x4* pr = (const LAS f32x4*)(sl + 256);
        float sa0 = 0.f, sa1 = 0.f;
#pragma unroll
        for (int j4 = 0; j4 < 16; ++j4) { const f32x4 q = pk[j4]; sa0 += S[4 * j4] * q.x + S[4 * j4 + 2] * q.z; sa1 += S[4 * j4 + 1] * q.y + S[4 * j4 + 3] * q.w; if ((j4 & 3) == 3) asm volatile("" ::: "memory"); }
        const float sa = sa0 + sa1;
        float y0 = 0.f, y1 = 0.f;
#pragma unroll
        for (int j4 = 0; j4 < 16; ++j4) {
            const f32x4 w4 = pw[j4], b4 = pb[j4], k4 = pm[j4], r4 = pr[j4];
            S[4 * j4 + 0] = S[4 * j4 + 0] * w4.x + (vi * k4.x - sa * b4.x); y0 += S[4 * j4 + 0] * r4.x;
            S[4 * j4 + 1] = S[4 * j4 + 1] * w4.y + (vi * k4.y - sa * b4.y); y1 += S[4 * j4 + 1] * r4.y;
            S[4 * j4 + 2] = S[4 * j4 + 2] * w4.z + (vi * k4.z - sa * b4.z); y0 += S[4 * j4 + 2] * r4.z;
            S[4 * j4 + 3] = S[4 * j4 + 3] * w4.w + (vi * k4.w - sa * b4.w); y1 += S[4 * j4 + 3] * r4.w;
            if ((j4 & 1) == 1) asm volatile("" ::: "memory");
        }
        const float y = y0 + y1;
        const float mean = wave_sum(y) * (1.0f / 64.0f); const float yc = y - mean;
        const float var = wave_sum(yc * yc) * (1.0f / 64.0f);
        float yn = yc * (1.0f / sqrtf(var + 64e-5f)) * gw_ + gb_;
        yn += bon * vi;
        const float gate = bf2f(C.PJ[(size_t)m * NP + C_GR + n]);
        C.MIX[(size_t)m * DM + n] = f2bf(yn * silu(gate));
        asm volatile("s_waitcnt lgkmcnt(0)" ::: "memory");
    }
    float* so = C.out + O_WKVS + ((size_t)(b * 8 + h) * 64 + lane) * 64;
#pragma unroll
    for (int j = 0; j < 64; j += 4) *(f32x4*)(so + j) = (f32x4){S[j], S[j + 1], S[j + 2], S[j + 3]};
}

namespace rk {
constexpr int LDB = 72, SLOT = 64 * LDB * 2, LDW = 68;
constexpr int OFF_WL = 8 * SLOT, OFF_AL = OFF_WL + 64 * LDW * 4, OFF_QT = 15 * SLOT, OFF_GL = OFF_QT + 8 * 64 * 4, OFF_END = OFF_GL + 256;
static_assert(OFF_AL + 64 * LDW * 4 <= 12 * SLOT && OFF_END <= MISC_OFF, "rk LDS map");
__device__ __forceinline__ int crow(int r, int hi) { return (r & 3) + 8 * (r >> 2) + 4 * hi; }
__device__ __forceinline__ LAS char* SL(LAS char* lds, int k) { return lds + k * SLOT; }
__device__ __forceinline__ bf16x8 frag(const LAS char* base, int blk, int ks, int r32, int hi) { return *(const LAS bf16x8*)(base + ((32 * blk + r32) * LDB + 16 * ks + 8 * hi) * 2); }
__device__ __forceinline__ void mm_tile(f32x16& acc, const LAS char* A, const LAS char* Bt, int tm, int tn, int r32, int hi) {
    bf16x8 fa[4], fb[4];
#pragma unroll
    for (int ks = 0; ks < 4; ++ks) { fa[ks] = frag(A, tm, ks, r32, hi); fb[ks] = frag(Bt, tn, ks, r32, hi); }
    __builtin_amdgcn_sched_barrier(0);
#pragma unroll
    for (int ks = 0; ks < 4; ++ks) acc = __builtin_amdgcn_mfma_f32_32x32x16_bf16(fa[ks], fb[ks], acc, 0, 0, 0);
}
__device__ __forceinline__ void store_T(LAS char* X, const f32x16& acc, int tm, int tn, int r32, int hi) {
#pragma unroll
    for (int g4 = 0; g4 < 4; ++g4) { u32x2 w; w.x = cvtpk(acc[4 * g4], acc[4 * g4 + 1]); w.y = cvtpk(acc[4 * g4 + 2], acc[4 * g4 + 3]); *(LAS u32x2*)(X + ((32 * tn + r32) * LDB + 32 * tm + 8 * g4 + 4 * hi) * 2) = w; }
}
__device__ __forceinline__ void store_R(LAS char* X, const f32x16& acc, int tm, int tn, int r32, int hi) {
#pragma unroll
    for (int r = 0; r < 16; ++r) *(LAS bf16_t*)(X + ((32 * tm + crow(r, hi)) * LDB + 32 * tn + r32) * 2) = f2bf(acc[r]);
}
__device__ __forceinline__ void unpack16(f32x16& a, const u32x4 lo, const u32x4 hi4) {
    a[0] = bflo(lo.x); a[1] = bfhi(lo.x); a[2] = bflo(lo.y); a[3] = bfhi(lo.y); a[4] = bflo(lo.z); a[5] = bfhi(lo.z); a[6] = bflo(lo.w); a[7] = bfhi(lo.w);
    a[8] = bflo(hi4.x); a[9] = bfhi(hi4.x); a[10] = bflo(hi4.y); a[11] = bfhi(hi4.y); a[12] = bflo(hi4.z); a[13] = bfhi(hi4.z); a[14] = bflo(hi4.w); a[15] = bfhi(hi4.w);
}
__device__ __forceinline__ u32x4 pack8(const f32x16& a, int s) { return (u32x4){cvtpk(a[8 * s], a[8 * s + 1]), cvtpk(a[8 * s + 2], a[8 * s + 3]), cvtpk(a[8 * s + 4], a[8 * s + 5]), cvtpk(a[8 * s + 6], a[8 * s + 7])}; }
constexpr int REC_GB = 0, REC_RB = 8192, REC_HB = 16384, REC_YB = 24576;

__device__ __forceinline__ void phaseA_loadWA(const Ctx& C, int b, int c, u32x4 (&z)[3]) {
    const int m0 = b * SEQ + c * 64;
#pragma unroll
    for (int k = 0; k < 3; ++k) {
        const int i = C.tid + 512 * k; const bool in = i < 65 * 16;
        const int rr = in ? i / 16 : 0, q = i % 16; const int col = ((q >> 3) ? C_AD : C_WD) + (q & 7) * 8;
        const bool has = in && (rr > 0 || c > 0);
        u32x4 v = *(const u32x4*)(C.PJ + (size_t)(m0 + rr - ((rr > 0 || c > 0) ? 1 : 0)) * NP + col);
        if (!has) v = (u32x4){0u, 0u, 0u, 0u};
        z[k] = v;
    }
}
__device__ __forceinline__ void phaseA_loadRKV(const Ctx& C, int b, int h, int c, u32x4 (&z)[4]) {
    const int m0 = b * SEQ + c * 64;
#pragma unroll
    for (int k = 0; k < 4; ++k) {
        const int i = C.tid + 512 * k; const bool in = i < 65 * 24;
        const int rr = in ? i / 24 : 0, q = i % 24; const int col = (q >> 3) * 512 + h * 64 + (q & 7) * 8;
        const bool has = in && (rr > 0 || c > 0);
        u32x4 v = *(const u32x4*)(C.PJ + (size_t)(m0 + rr - ((rr > 0 || c > 0) ? 1 : 0)) * NP + col);
        if (!has) v = (u32x4){0u, 0u, 0u, 0u};
        z[k] = v;
    }
}
struct ChanConst { float w0, a0, kk, ka, rk, mur, muk, muv, muw, mua; };
__device__ __forceinline__ void phaseA_item(const Ctx& C, LAS char* lds, int b, int h, int c, u32x4 (&zwa)[3], bool has_next, int nb, int nc, const ChanConst& cc) {
    const int tid = C.tid, lane = C.lane, wid = C.wid, r32 = lane & 31, hi = lane >> 5;
    const int gr = wid >> 2, w4 = wid & 3, tm = w4 >> 1, tn = w4 & 1;
    const int m0 = b * SEQ + c * 64;
    const int n = h * 64 + lane;
    unsigned char* rec = C.CHK + (size_t)((b * 8 + h) * 32 + c) * CHK_BYTES;
    LAS float* QT = (LAS float*)(lds + OFF_QT); LAS float* GL = (LAS float*)(lds + OFF_GL);
    LDS_BAR();
    bf16x8 wfr[4];
    {
        const bf16_t* WT = (gr == 0 ? C.WduT : C.WauT) + (size_t)(h * 64 + 32 * tn + r32) * 64 + 8 * hi;
#pragma unroll
        for (int ks = 0; ks < 4; ++ks) wfr[ks] = *(const bf16x8*)(WT + 16 * ks);
    }
    u32x4 zrkv[4];
    {
        LAS char* Z = SL(lds, 0);
#pragma unroll
        for (int k = 0; k < 3; ++k) { const int i = tid + 512 * k; if (i < 65 * 16) { const int rr = i / 16, q = i % 16; *(LAS u32x4*)(Z + (rr * 5 + 3 + (q >> 3)) * 128 + (q & 7) * 16) = zwa[k]; } }
        phaseA_loadRKV(C, b, h, c, zrkv);
    }
    LDS_BAR();
    const LAS bf16_t* Zb = (const LAS bf16_t*)SL(lds, 0);
#define ZSH(t, seg, mu_) ({ const float z_ = bf2f(Zb[(((t) + 1) * 5 + (seg)) * 64 + lane]), zp_ = bf2f(Zb[((t) * 5 + (seg)) * 64 + lane]); z_ + (zp_ - z_) * (mu_); })
    {
        LAS bf16_t* TW = (LAS bf16_t*)SL(lds, 13); LAS bf16_t* AD = (LAS bf16_t*)SL(lds, 14);
        const float muw = cc.muw, mua = cc.mua;
#pragma unroll
        for (int tk = 0; tk < 8; ++tk) {
            const int t = 8 * wid + tk;
            TW[t * LDB + lane] = f2bf(ftanh(ZSH(t, 3, muw)));
            AD[t * LDB + lane] = f2bf(ZSH(t, 4, mua));
        }
    }
    LDS_BAR();
    {
        f32x16 acc = (f32x16){};
        const LAS char* A = SL(lds, gr == 0 ? 13 : 14);
#pragma unroll
        for (int ks = 0; ks < 4; ++ks) acc = __builtin_amdgcn_mfma_f32_32x32x16_bf16(frag(A, tm, ks, r32, hi), wfr[ks], acc, 0, 0, 0);
        LAS float* X = (LAS float*)(lds + (gr == 0 ? OFF_WL : OFF_AL));
#pragma unroll
        for (int g4 = 0; g4 < 4; ++g4) *(LAS f32x4*)(X + (32 * tn + r32) * LDW + 32 * tm + 8 * g4 + 4 * hi) = (f32x4){acc[4 * g4], acc[4 * g4 + 1], acc[4 * g4 + 2], acc[4 * g4 + 3]};
    }
    {
        LAS char* Z = SL(lds, 0);
#pragma unroll
        for (int k = 0; k < 4; ++k) { const int i = tid + 512 * k; if (i < 65 * 24) { const int rr = i / 24, q = i % 24; *(LAS u32x4*)(Z + (rr * 5 + (q >> 3)) * 128 + (q & 7) * 16) = zrkv[k]; } }
    }
    LDS_BAR();
    {
        float lw[8], kkv[8], bav[8], kmv[8], rv[8], vv[8], cl[8];
        const LAS float* WLp = (const LAS float*)(lds + OFF_WL) + lane * LDW + 8 * wid; const LAS float* ALp = (const LAS float*)(lds + OFF_AL) + lane * LDW + 8 * wid;
        const f32x4 wa = *(const LAS f32x4*)WLp, wb = *(const LAS f32x4*)(WLp + 4), aa = *(const LAS f32x4*)ALp, ab = *(const LAS f32x4*)(ALp + 4);
        const float wlv[8] = {wa.x, wa.y, wa.z, wa.w, wb.x, wb.y, wb.z, wb.w}, alv[8] = {aa.x, aa.y, aa.z, aa.w, ab.x, ab.y, ab.z, ab.w};
        const float w0n = cc.w0, a0n = cc.a0, kkn = cc.kk, kan = cc.ka, rkn = cc.rk;
        const float mur = cc.mur, muk = cc.muk, muv = cc.muv;
        float csum = 0.f;
#pragma unroll
        for (int tk = 0; tk < 8; ++tk) {
            const int m = m0 + 8 * wid + tk;
            const float r = ZSH(8 * wid + tk, 0, mur), k = ZSH(8 * wid + tk, 1, muk), v = ZSH(8 * wid + tk, 2, muv);
            const float x = -(wlv[tk] + w0n);
            const float sp = fmaxf(x, 0.f) + __logf(1.f + fexp(-fabsf(x)));
            lw[tk] = -fexp(-sp - 0.5f);
            const float a = fsigm(alv[tk] + a0n);
            float kk = k * kkn;
            const float ss = wave_sum_dpp(kk * kk);
            kk *= rsqrtf(fmaxf(ss, 1e-24f));
            const float km = k * (1.0f + (a - 1.0f) * kan);
            const float bon = wave_sum_dpp(r * km * rkn);
            if (lane == 0) C.BONUS[(size_t)m * 8 + h] = bon;
            kkv[tk] = kk; bav[tk] = kk * a; kmv[tk] = km; rv[tk] = r; vv[tk] = v;
            csum += lw[tk]; cl[tk] = csum;
        }
        QT[wid * 64 + lane] = csum;
        LDS_BAR();
        float base = 0.f, total = 0.f;
#pragma unroll
        for (int q = 0; q < 8; ++q) { const float tq = QT[q * 64 + lane]; total += tq; if (q < wid) base += tq; }
        if (wid == 0) GL[lane] = fexp(total);
        LAS bf16_t* Rt = (LAS bf16_t*)SL(lds, 0); LAS bf16_t* At = (LAS bf16_t*)SL(lds, 5); LAS bf16_t* Bt = (LAS bf16_t*)SL(lds, 6); LAS bf16_t* Kt = (LAS bf16_t*)SL(lds, 7);
        float atv[8], bhv[8], khv[8];
#pragma unroll
        for (int tk = 0; tk < 8; ++tk) {
            const int t = 8 * wid + tk;
            const float cum = base + cl[tk], cprev = cum - lw[tk];
            const float g = fexp(cum), gp = fexp(cprev), gi = fexp(-cum), gl = fexp(total - cum);
            atv[tk] = kkv[tk] * gp; bhv[tk] = bav[tk] * gl; khv[tk] = kmv[tk] * gl;
            At[t * LDB + lane] = f2bf(atv[tk]); Bt[t * LDB + lane] = f2bf(bav[tk] * gi); Kt[t * LDB + lane] = f2bf(kmv[tk] * gi); Rt[t * LDB + lane] = f2bf(rv[tk] * g);
        }
        const int co = (lane * LDB + 8 * wid) * 2;
        *(LAS u32x4*)(SL(lds, 1) + co) = (u32x4){cvtpk(atv[0], atv[1]), cvtpk(atv[2], atv[3]), cvtpk(atv[4], atv[5]), cvtpk(atv[6], atv[7])};
        *(LAS u32x4*)(SL(lds, 2) + co) = (u32x4){cvtpk(vv[0], vv[1]), cvtpk(vv[2], vv[3]), cvtpk(vv[4], vv[5]), cvtpk(vv[6], vv[7])};
        *(LAS u32x4*)(SL(lds, 3) + co) = (u32x4){cvtpk(bhv[0], bhv[1]), cvtpk(bhv[2], bhv[3]), cvtpk(bhv[4], bhv[5]), cvtpk(bhv[6], bhv[7])};
        *(LAS u32x4*)(SL(lds, 4) + co) = (u32x4){cvtpk(khv[0], khv[1]), cvtpk(khv[2], khv[3]), cvtpk(khv[4], khv[5]), cvtpk(khv[6], khv[7])};
    }
    LDS_BAR();
#undef ZSH
    f32x16 Tt = (f32x16){}, hacc = (f32x16){}, yacc = (f32x16){};
    const int colg = 32 * tn + r32;
    int dm = colg - 32 * tm - 4 * hi; asm volatile("" : "+v"(dm));
#define CRW(r) (((r) & 3) + 8 * ((r) >> 2))
    if (gr == 0) {
        f32x16 acc = (f32x16){}; mm_tile(acc, SL(lds, 5), SL(lds, 6), tm, tn, r32, hi);
#pragma unroll
        for (int r = 0; r < 16; ++r) { const float y = (dm < CRW(r)) ? -acc[r] : 0.f; acc[r] = y; Tt[r] = y + ((dm == CRW(r)) ? 1.f : 0.f); }
        store_R(SL(lds, 8), acc, tm, tn, r32, hi); store_T(SL(lds, 9), acc, tm, tn, r32, hi); store_T(SL(lds, 13), Tt, tm, tn, r32, hi);
        acc = (f32x16){}; mm_tile(acc, SL(lds, 6), SL(lds, 0), tm, tn, r32, hi);
#pragma unroll
        for (int r = 0; r < 16; ++r) acc[r] = (CRW(r) <= dm) ? acc[r] : 0.f;
        store_T(SL(lds, 11), acc, tm, tn, r32, hi);
    } else {
        f32x16 acc = (f32x16){}; mm_tile(acc, SL(lds, 7), SL(lds, 5), tm, tn, r32, hi);
#pragma unroll
        for (int r = 0; r < 16; ++r) acc[r] = (CRW(r) < dm) ? acc[r] : 0.f;
        store_T(SL(lds, 10), acc, tm, tn, r32, hi);
        acc = (f32x16){}; mm_tile(acc, SL(lds, 7), SL(lds, 0), tm, tn, r32, hi);
#pragma unroll
        for (int r = 0; r < 16; ++r) acc[r] = (CRW(r) <= dm) ? acc[r] : 0.f;
        store_T(SL(lds, 12), acc, tm, tn, r32, hi);
    }
    LDS_BAR();
    if (gr == 1) { f32x16 acc = (f32x16){}; mm_tile(acc, SL(lds, 8), SL(lds, 9), tm, tn, r32, hi); store_R(SL(lds, 5), acc, tm, tn, r32, hi); store_T(SL(lds, 6), acc, tm, tn, r32, hi); }
    else { f32x16 acc = (f32x16){}; mm_tile(acc, SL(lds, 10), SL(lds, 2), tm, tn, r32, hi); store_T(SL(lds, 7), acc, tm, tn, r32, hi); }
    LDS_BAR();
#pragma unroll 1
    for (int k = 1; k <= 4; ++k) {
        const int yc = (k & 1) ? 5 : 8, ynx = (k & 1) ? 8 : 5, ttc = (k & 1) ? 13 : 14, ttn = (k & 1) ? 14 : 13;
        if (gr == 0) { mm_tile(Tt, SL(lds, yc), SL(lds, ttc), tm, tn, r32, hi); store_T(SL(lds, ttn), Tt, tm, tn, r32, hi); }
        else { f32x16 acc = (f32x16){}; mm_tile(acc, SL(lds, yc), SL(lds, yc + 1), tm, tn, r32, hi); store_R(SL(lds, ynx), acc, tm, tn, r32, hi); store_T(SL(lds, ynx + 1), acc, tm, tn, r32, hi); }
        LDS_BAR();
    }
    if (gr == 0) { mm_tile(Tt, SL(lds, 5), SL(lds, 13), tm, tn, r32, hi); store_R(SL(lds, 14), Tt, tm, tn, r32, hi); }
    else { mm_tile(hacc, SL(lds, 4), SL(lds, 2), tm, tn, r32, hi); mm_tile(yacc, SL(lds, 2), SL(lds, 12), tm, tn, r32, hi); }
    LDS_BAR();
    if (has_next) phaseA_loadWA(C, nb, nc, zwa);
    if (gr == 0) { f32x16 acc = (f32x16){}; mm_tile(acc, SL(lds, 14), SL(lds, 1), tm, tn, r32, hi); store_T(SL(lds, 8), acc, tm, tn, r32, hi); }
    else { f32x16 acc = (f32x16){}; mm_tile(acc, SL(lds, 14), SL(lds, 7), tm, tn, r32, hi); store_T(SL(lds, 9), acc, tm, tn, r32, hi); }
    LDS_BAR();
#if (DUPMASK >> 9) & 1
    if (gr == 0) { f32x16 acc = (f32x16){}; mm_tile(acc, SL(lds, 14), SL(lds, 1), tm, tn, r32, hi); store_T(SL(lds, 8), acc, tm, tn, r32, hi); }
    else { f32x16 acc = (f32x16){}; mm_tile(acc, SL(lds, 14), SL(lds, 7), tm, tn, r32, hi); store_T(SL(lds, 9), acc, tm, tn, r32, hi); }
    LDS_BAR();
#endif
    if (gr == 0) {
        f32x16 acc = (f32x16){}; mm_tile(acc, SL(lds, 8), SL(lds, 3), tm, tn, r32, hi);
        const float glc = GL[colg];
        int dm9 = colg - 32 * tm - 4 * hi; asm volatile("" : "+v"(dm9));
#pragma unroll
        for (int r = 0; r < 16; ++r) acc[r] = ((dm9 == CRW(r)) ? glc : 0.f) - acc[r];
        u32x4* gb = (u32x4*)(rec + REC_GB);
        gb[((tm * 2 + tn) * 2 + 0) * 64 + lane] = pack8(acc, 0); gb[((tm * 2 + tn) * 2 + 1) * 64 + lane] = pack8(acc, 1);
        acc = (f32x16){}; mm_tile(acc, SL(lds, 8), SL(lds, 11), tm, tn, r32, hi);
        const LAS bf16_t* Rt = (const LAS bf16_t*)SL(lds, 0);
#pragma unroll
        for (int g4 = 0; g4 < 4; ++g4) {
            const u32x2 w = *(const LAS u32x2*)(Rt + colg * LDB + 32 * tm + 8 * g4 + 4 * hi);
            acc[4 * g4] = bflo(w.x) - acc[4 * g4]; acc[4 * g4 + 1] = bfhi(w.x) - acc[4 * g4 + 1]; acc[4 * g4 + 2] = bflo(w.y) - acc[4 * g4 + 2]; acc[4 * g4 + 3] = bfhi(w.y) - acc[4 * g4 + 3];
        }
        u32x4* rb = (u32x4*)(rec + REC_RB);
        rb[((tm * 2 + tn) * 2 + 0) * 64 + lane] = pack8(acc, 0); rb[((tm * 2 + tn) * 2 + 1) * 64 + lane] = pack8(acc, 1);
    } else {
        f32x16 acc = (f32x16){}; mm_tile(acc, SL(lds, 3), SL(lds, 9), tm, tn, r32, hi);
#pragma unroll
        for (int r = 0; r < 16; ++r) hacc[r] -= acc[r];
        u32x4* hb = (u32x4*)(rec + REC_HB);
        hb[((tm * 2 + tn) * 2 + 0) * 64 + lane] = pack8(hacc, 0); hb[((tm * 2 + tn) * 2 + 1) * 64 + lane] = pack8(hacc, 1);
        acc = (f32x16){}; mm_tile(acc, SL(lds, 9), SL(lds, 11), tm, tn, r32, hi);
#pragma unroll
        for (int r = 0; r < 16; ++r) yacc[r] -= acc[r];
        u32x4* yb = (u32x4*)(rec + REC_YB);
        yb[((tm * 2 + tn) * 2 + 0) * 64 + lane] = pack8(yacc, 0); yb[((tm * 2 + tn) * 2 + 1) * 64 + lane] = pack8(yacc, 1);
    }
}

__device__ __forceinline__ void bc_state_pass(const Ctx& C, LAS char* lds, int u  ) {
    const int lane = C.lane, r32 = lane & 31, hi = lane >> 5, wid = C.wid, w4 = wid & 3, tp = w4 >> 1, tn = w4 & 1, grp = wid >> 2;
    f32x16 X = (f32x16){};
    LAS u32x4* PW = (LAS u32x4*)(lds + grp * 16384);
    const unsigned char* rec0 = C.CHK + (size_t)u * 32 * CHK_BYTES;
    u32x4 gbn[4], hbn[2];
    {
        const u32x4* gb = (const u32x4*)(rec0 + REC_GB); const u32x4* hb = (const u32x4*)(rec0 + REC_HB);
#pragma unroll
        for (int q = 0; q < 4; ++q) gbn[q] = gb[(((q >> 1) * 2 + tp) * 2 + (q & 1)) * 64 + lane];
        hbn[0] = hb[((tp * 2 + tn) * 2 + 0) * 64 + lane]; hbn[1] = hb[((tp * 2 + tn) * 2 + 1) * 64 + lane];
    }
#pragma unroll 1
    for (int c = 0; c < 32; ++c) {
        u32x4 gbc[4], hbc[2];
#pragma unroll
        for (int q = 0; q < 4; ++q) gbc[q] = gbn[q];
        hbc[0] = hbn[0]; hbc[1] = hbn[1];
        if (c + 1 < 32) {
            const unsigned char* rec = rec0 + (size_t)(c + 1) * CHK_BYTES;
            const u32x4* gb = (const u32x4*)(rec + REC_GB); const u32x4* hb = (const u32x4*)(rec + REC_HB);
#pragma unroll
            for (int q = 0; q < 4; ++q) gbn[q] = gb[(((q >> 1) * 2 + tp) * 2 + (q & 1)) * 64 + lane];
            hbn[0] = hb[((tp * 2 + tn) * 2 + 0) * 64 + lane]; hbn[1] = hb[((tp * 2 + tn) * 2 + 1) * 64 + lane];
        }
        const u32x4 p0 = pack8(X, 0), p1 = pack8(X, 1);
        LAS u32x4* pwb = PW + (c & 1) * 512;
        pwb[((tp * 2 + tn) * 2 + 0) * 64 + lane] = p0; pwb[((tp * 2 + tn) * 2 + 1) * 64 + lane] = p1;
        u32x4* s0 = (u32x4*)(C.S0R + ((size_t)u * 32 + c) * 8192);
        s0[((tp * 2 + tn) * 2 + 0) * 64 + lane] = p0; s0[((tp * 2 + tn) * 2 + 1) * 64 + lane] = p1;
        __syncthreads();
        f32x16 acc; unpack16(acc, hbc[0], hbc[1]);
#pragma unroll
        for (int q = 0; q < 4; ++q) {
            const u32x4 bw = pwb[(((q >> 1) * 2 + tn) * 2 + (q & 1)) * 64 + lane];
            acc = __builtin_amdgcn_mfma_f32_32x32x16_bf16(__builtin_bit_cast(bf16x8, gbc[q]), __builtin_bit_cast(bf16x8, bw), acc, 0, 0, 0);
        }
        X = acc;
    }
    float* so = C.out + O_WKVP + (size_t)u * 4096;
#pragma unroll
    for (int g4 = 0; g4 < 4; ++g4) *(f32x4*)(so + (32 * tn + r32) * 64 + 32 * tp + 8 * g4 + 4 * hi) = (f32x4){X[4 * g4], X[4 * g4 + 1], X[4 * g4 + 2], X[4 * g4 + 3]};
}

__device__ __forceinline__ void bc_output_wave(const Ctx& C, int u, int c, int tt, const LAS float* cst  ) {
    const int lane = C.lane, r32 = lane & 31, hi = lane >> 5, b = u >> 3, h = u & 7;
    const unsigned char* rec = C.CHK + ((size_t)u * 32 + c) * CHK_BYTES;
    const u32x4* rb = (const u32x4*)(rec + REC_RB); const u32x4* s0 = (const u32x4*)(C.S0R + ((size_t)u * 32 + c) * 8192);
    const bf16_t* PJ = C.PJ;
    const int t = c * 64 + 32 * tt + r32; const size_t m = (size_t)b * SEQ + t;
    u32x2 zv[8], zp[8], gt[8];
    const size_t mprev = m - (t > 0 ? 1 : 0);
#pragma unroll
    for (int q = 0; q < 8; ++q) {
        const int nn = h * 64 + 32 * (q >> 2) + 8 * (q & 3) + 4 * hi;
        zv[q] = *(const u32x2*)(PJ + m * NP + C_V + nn); zp[q] = *(const u32x2*)(PJ + mprev * NP + C_V + nn); gt[q] = *(const u32x2*)(PJ + m * NP + C_GR + nn);
    }
    const float bon = C.BONUS[m * 8 + h];
    f32x16 Y[2];
#pragma unroll
    for (int ti = 0; ti < 2; ++ti) {
        const u32x4* yb = (const u32x4*)(rec + REC_YB);
        f32x16 acc; unpack16(acc, yb[((ti * 2 + tt) * 2 + 0) * 64 + lane], yb[((ti * 2 + tt) * 2 + 1) * 64 + lane]);
#pragma unroll
        for (int tm = 0; tm < 2; ++tm)
#pragma unroll
            for (int sx = 0; sx < 2; ++sx)
                acc = __builtin_amdgcn_mfma_f32_32x32x16_bf16(__builtin_bit_cast(bf16x8, s0[((tm * 2 + ti) * 2 + sx) * 64 + lane]), __builtin_bit_cast(bf16x8, rb[((tm * 2 + tt) * 2 + sx) * 64 + lane]), acc, 0, 0, 0);
        Y[ti] = acc;
    }
    float s1 = 0.f;
#pragma unroll
    for (int r = 0; r < 16; ++r) s1 += Y[0][r] + Y[1][r];
    s1 += __shfl_xor(s1, 32);
    const float mean = s1 * (1.0f / 64.0f);
    float s2 = 0.f;
#pragma unroll
    for (int r = 0; r < 16; ++r) { const float d0 = Y[0][r] - mean, d1 = Y[1][r] - mean; s2 += d0 * d0 + d1 * d1; }
    s2 += __shfl_xor(s2, 32);
    const float rstd = 1.0f / sqrtf(s2 * (1.0f / 64.0f) + 64e-5f);
#pragma unroll
    for (int q = 0; q < 8; ++q) {
        const int ti = q >> 2, g4 = q & 3, nn = h * 64 + 32 * ti + 8 * g4 + 4 * hi;
        const f32x4 mu = *(const LAS f32x4*)(cst + nn), gw = *(const LAS f32x4*)(cst + 512 + nn), gb4 = *(const LAS f32x4*)(cst + 1024 + nn);
        const float v[4] = {bflo(zv[q].x), bfhi(zv[q].x), bflo(zv[q].y), bfhi(zv[q].y)};
        float vp[4] = {bflo(zp[q].x), bfhi(zp[q].x), bflo(zp[q].y), bfhi(zp[q].y)};
        if (t == 0) { vp[0] = 0.f; vp[1] = 0.f; vp[2] = 0.f; vp[3] = 0.f; }
        const float muv[4] = {mu.x, mu.y, mu.z, mu.w}, gate[4] = {bflo(gt[q].x), bfhi(gt[q].x), bflo(gt[q].y), bfhi(gt[q].y)}, gwv[4] = {gw.x, gw.y, gw.z, gw.w}, gbv[4] = {gb4.x, gb4.y, gb4.z, gb4.w};
        float o[4];
#pragma unroll
        for (int e = 0; e < 4; ++e) {
            const float vs = v[e] + (vp[e] - v[e]) * muv[e];
            const float yn = (Y[ti][4 * g4 + e] - mean) * rstd * gwv[e] + gbv[e] + bon * vs;
            o[e] = yn * fsilu(gate[e]);
        }
        u32x2 w; w.x = cvtpk(o[0], o[1]); w.y = cvtpk(o[2], o[3]);
        *(u32x2*)(C.MIX + m * DM + nn) = w;
    }
}
}

__device__ __forceinline__ void p2_rwkv_chunks(const Ctx& C, LAS unsigned char* lds) {
    u32x4 zwa[3];
    int it = C.bid;
    const int n_ = (C.bid & 7) * 64 + C.lane;
    const rk::ChanConst cc{C.w0[n_], C.a0[n_], C.k_k[n_], C.k_a[n_], C.r_k[n_], C.mu[C_R + n_], C.mu[C_K + n_], C.mu[C_V + n_], C.mu[C_WD + C.lane], C.mu[C_AD + C.lane]};
    if (it < BATCH * 8 * 32) rk::phaseA_loadWA(C, it >> 8, (it >> 3) & 31, zwa);
#pragma unroll 1
    for (; it < BATCH * 8 * 32; it += C.G) {
        const int nx = it + C.G; const bool hn = nx < BATCH * 8 * 32;
        rk::phaseA_item(C, (LAS char*)lds, it >> 8, it & 7, (it >> 3) & 31, zwa, hn, nx >> 8, (nx >> 3) & 31, cc);
    }
    __syncthreads();
}

namespace att {
constexpr int OFF_K = 0, OFF_V = 24576, OFF_IMP = 49152, IMP_LD = 129, OFF_SC = OFF_IMP + 64 * IMP_LD * 4, SC_LD = 33;
constexpr int OFF_STG = 49152;
constexpr int OFF_SEL = OFF_STG + 8 * 8192, OFF_WSF = OFF_SEL + 512, OFF_END = OFF_WSF + 8 * 64 * 4;
static_assert(OFF_SC + 64 * SC_LD * 4 <= OFF_SEL && OFF_END <= MISC_OFF, "attention LDS map");
__device__ __forceinline__ int crow(int r, int hi) { return (r & 3) + 8 * (r >> 2) + 4 * hi; }
__device__ __forceinline__ s16x4 vtr(const LAS char* p) {
    typedef short v4i16_t __attribute__((ext_vector_type(4)));
    return __builtin_bit_cast(s16x4, __builtin_amdgcn_ds_read_tr16_b64_v4i16((LAS v4i16_t*)p));
}
__device__ __forceinline__ void stage_kv(const bf16_t* Kg, const bf16_t* Vg, size_t pitch, int key0, LAS char* Ks, LAS char* Vs, int tid) {
    const int key = tid >> 3, ch = tid & 7;
    const u32x4 kv = *(const u32x4*)(Kg + (size_t)(key0 + key) * pitch + ch * 8);
    const u32x4 vv = *(const u32x4*)(Vg + (size_t)(key0 + key) * pitch + ch * 8);
    *(LAS u32x4*)(Ks + ch * 1024 + key * 16) = kv;
    *(LAS u32x4*)(Vs + (ch >> 2) * 4096 + key * 64 + (ch & 3) * 16) = vv;
}
__device__ __forceinline__ void qk(f32x16& p0, f32x16& p1, const LAS char* Ks, const bf16x8 (&qr)[4], int r32, int hi) {
    p0 = (f32x16){}; p1 = (f32x16){};
#pragma unroll
    for (int d0 = 0; d0 < 4; ++d0) {
        const bf16x8 a0 = *(const LAS bf16x8*)(Ks + (2 * d0 + hi) * 1024 + r32 * 16);
        const bf16x8 a1 = *(const LAS bf16x8*)(Ks + (2 * d0 + hi) * 1024 + 512 + r32 * 16);
        p0 = __builtin_amdgcn_mfma_f32_32x32x16_bf16(a0, qr[d0], p0, 0, 0, 0);
        p1 = __builtin_amdgcn_mfma_f32_32x32x16_bf16(a1, qr[d0], p1, 0, 0, 0);
    }
}
__device__ __forceinline__ int imax3(int a, int b, int c) { const int t = a > b ? a : b; return t > c ? t : c; }
__device__ __forceinline__ void pack_p(u32x4 (&pw)[4], const f32x16& p0, const f32x16& p1) {
    pw[0] = (u32x4){cvtpk(p0[0], p0[1]), cvtpk(p0[2], p0[3]), cvtpk(p0[4], p0[5]), cvtpk(p0[6], p0[7])};
    pw[1] = (u32x4){cvtpk(p0[8], p0[9]), cvtpk(p0[10], p0[11]), cvtpk(p0[12], p0[13]), cvtpk(p0[14], p0[15])};
    pw[2] = (u32x4){cvtpk(p1[0], p1[1]), cvtpk(p1[2], p1[3]), cvtpk(p1[4], p1[5]), cvtpk(p1[6], p1[7])};
    pw[3] = (u32x4){cvtpk(p1[8], p1[9]), cvtpk(p1[10], p1[11]), cvtpk(p1[12], p1[13]), cvtpk(p1[14], p1[15])};
}
__device__ __forceinline__ void pv_packed(f32x16 (&o)[2], const u32x4 (&pw)[4], const LAS char* Vs, int vbase) {
#pragma unroll
    for (int dt = 0; dt < 2; ++dt)
#pragma unroll
        for (int ks = 0; ks < 4; ++ks) {
            const s16x4 lo = vtr(Vs + vbase + dt * 4096 + ks * 1024), hi4 = vtr(Vs + vbase + dt * 4096 + ks * 1024 + 512);
            const bf16x8 vf = (bf16x8){lo[0], lo[1], lo[2], lo[3], hi4[0], hi4[1], hi4[2], hi4[3]};
            o[dt] = __builtin_amdgcn_mfma_f32_32x32x16_bf16(__builtin_bit_cast(bf16x8, pw[ks]), vf, o[dt], 0, 0, 0);
        }
}
__device__ __forceinline__ void accum_scaled(f32x16 (&ot)[2], const f32x16 (&o)[2], float fac, LAS float* wsf, int r32, int hi) {
    if (hi == 0) wsf[r32] = fac;
    asm volatile("s_waitcnt lgkmcnt(0)" ::: "memory");
#pragma unroll
    for (int r = 0; r < 16; ++r) { const float f = wsf[crow(r, hi)]; ot[0][r] += o[0][r] * f; ot[1][r] += o[1][r] * f; }
    asm volatile("s_waitcnt lgkmcnt(0)" ::: "memory");
}
struct KVRegs { u32x4 k, v; };
__device__ __forceinline__ KVRegs kv_load(const bf16_t* Kg, const bf16_t* Vg, size_t pitch, int key0, int tid) {
    const int key = tid >> 3, ch = tid & 7; KVRegs r;
    r.k = *(const u32x4*)(Kg + (size_t)(key0 + key) * pitch + ch * 8);
    r.v = *(const u32x4*)(Vg + (size_t)(key0 + key) * pitch + ch * 8);
    return r;
}
__device__ __forceinline__ void kv_store(const KVRegs& r, LAS char* Ks, LAS char* Vs, int tid) {
    const int key = tid >> 3, ch = tid & 7;
    *(LAS u32x4*)(Ks + ch * 1024 + key * 16) = r.k;
    *(LAS u32x4*)(Vs + (ch >> 2) * 4096 + key * 64 + (ch & 3) * 16) = r.v;
}
__device__ __forceinline__ float ex2(float x) { return __builtin_amdgcn_exp2f(x); }
__device__ __forceinline__ float hmax(float v) {
    const unsigned u = __float_as_uint(v);
    auto rr = __builtin_amdgcn_permlane32_swap(u, u, false, false);
    return fmaxf(__uint_as_float(rr[0]), __uint_as_float(rr[1]));
}
__device__ __forceinline__ float hsum(float v) {
    const unsigned u = __float_as_uint(v);
    auto rr = __builtin_amdgcn_permlane32_swap(u, u, false, false);
    return __uint_as_float(rr[0]) + __uint_as_float(rr[1]);
}
__device__ __forceinline__ void glds16(const void* gsrc, unsigned lds_dst) {
    unsigned keep;
    asm volatile("s_mov_b32 %0, m0\n\ts_mov_b32 m0, %2\n\ts_nop 0\n\tglobal_load_lds_dwordx4 %1, off\n\ts_mov_b32 m0, %0" : "=&s"(keep) : "v"(gsrc), "s"(lds_dst) : "memory");
}
__device__ __forceinline__ void k_dma(const bf16_t* Kg, size_t pitch, int key0, LAS char* Ks, int wid, int lane) {
    glds16(Kg + (size_t)(key0 + lane) * pitch + wid * 8, (unsigned)__builtin_amdgcn_readfirstlane((int)(unsigned)(uintptr_t)(Ks + wid * 1024)));
}
__device__ __forceinline__ void v_dma(const bf16_t* Vg, size_t pitch, int key0, LAS char* Vs, int wid, int lane) {
    glds16(Vg + (size_t)(key0 + 16 * (wid & 3) + (lane >> 2)) * pitch + (wid >> 2) * 32 + (lane & 3) * 8, (unsigned)__builtin_amdgcn_readfirstlane((int)(unsigned)(uintptr_t)(Vs + (wid >> 2) * 4096 + (wid & 3) * 1024)));
}
__device__ __forceinline__ int pop_bit(unsigned& m) { const int t = __builtin_ctz(m); m &= m - 1u; return t; }

__device__ __forceinline__ void attn_prompt_unit(const Ctx& C, LAS char* lds, int b, int kvh, int qb) {
    const int tid = C.tid, lane = C.lane, r32 = lane & 31, hi = lane >> 5, wid = C.wid;
    const int g = wid >> 1, th = wid & 1, h = kvh * 4 + g;
    const int t0 = qb * 64; const int tq = t0 + 32 * th + r32;
    const size_t mq = (size_t)b * SEQ + tq;
    const bf16_t* PJ = C.PJ;
    bf16x8 qr[4]; float gate0 = 0.f, gate1 = 0.f, gate2 = 0.f;
    LAS float* wsf = (LAS float*)(lds + OFF_WSF) + wid * 64;
    LAS float* stg = (LAS float*)(lds + OFF_STG) + wid * 2048;
    const int vbase = ((lane >> 4) & 1) * 32 + (lane & 3) * 8 + (4 * hi + ((lane & 15) >> 2)) * 64;
    LAS unsigned* selm = (LAS unsigned*)(lds + OFF_SEL);
    LAS float* imp = (LAS float*)(lds + OFF_IMP);
    const int jmax = (tq >= 31) ? ((tq - 31) >> 4) : -1;
    unsigned mysel = 0u, usel = 0u;
    const bf16x8 ones = (bf16x8){0x3F80, 0x3F80, 0x3F80, 0x3F80, 0x3F80, 0x3F80, 0x3F80, 0x3F80};
    unsigned mDs = 0u, mDw = 0u; int slot = 0;
    const bf16_t* Kg1 = PJ + (size_t)b * SEQ * NP + C_KV + 2 * 128 + kvh * 64;
#define DMA_NEXT12(RS) do { const bf16_t* base_; int t_; if (mDs) { t_ = pop_bit(mDs); base_ = Kg1; } else { t_ = pop_bit(mDw); base_ = Kg1 + 256; } \
        k_dma(base_, NP, t_ * 64, lds + OFF_K + (RS) * 8192, wid, lane); v_dma(base_ + 128, NP, t_ * 64, lds + OFF_V + (RS) * 8192, wid, lane); } while (0)
#pragma unroll 1
    for (int br = 0; br < 3; ++br) {
        const bf16_t* Kg; const bf16_t* Vg; size_t pitch; unsigned tmask;
        if (br == 0) { Kg = C.CMPK_P + (size_t)(b * 2 + kvh) * 128 * 64; Vg = C.CMPV_P + (size_t)(b * 2 + kvh) * 128 * 64; pitch = 64; tmask = 3u; }
        else { const int tlo = (qb - 8) > 0 ? (qb - 8) : 0; const unsigned wmask = ((2u << qb) - 1u) & ~((1u << tlo) - 1u);
               Kg = Kg1; Vg = Kg1; pitch = NP; if (br == 1) { tmask = usel; mDs = usel; mDw = wmask; } else tmask = wmask; }
        const int n = __builtin_popcount(tmask);
        unsigned mC = tmask, mD = tmask;
        float m_run = 0.f; f32x16 o[2], lacc, negm; o[0] = (f32x16){}; o[1] = (f32x16){}; lacc = (f32x16){}; negm = (f32x16){};
        if (br == 1) __builtin_amdgcn_s_waitcnt(0x0F70);
        asm volatile("s_waitcnt lgkmcnt(0)" ::: "memory"); __builtin_amdgcn_s_barrier(); asm volatile("" ::: "memory");
        if (br == 0) {
            { const int t = pop_bit(mD); k_dma(Kg, pitch, t * 64, lds + OFF_K, wid, lane); v_dma(Vg, pitch, t * 64, lds + OFF_V, wid, lane); }
            if (n > 1) { const int t = pop_bit(mD); k_dma(Kg, pitch, t * 64, lds + OFF_K + 8192, wid, lane); v_dma(Vg, pitch, t * 64, lds + OFF_V + 8192, wid, lane); }
            slot = 0;
        } else if (br == 1) { DMA_NEXT12(0); DMA_NEXT12(1); slot = 0; }
        if (br == 0) {
#pragma unroll
            for (int d0 = 0; d0 < 4; ++d0) qr[d0] = *(const bf16x8*)(PJ + mq * NP + C_Q + h * 64 + 16 * d0 + 8 * hi);
            const bf16_t g0 = PJ[mq * NP + C_GL + h], g1 = PJ[mq * NP + C_GL + 8 + h], g2 = PJ[mq * NP + C_GL + 16 + h];
            __builtin_amdgcn_s_waitcnt(0x0F70);
            gate0 = sigm(bf2f(g0)); gate1 = sigm(bf2f(g1)); gate2 = sigm(bf2f(g2));
        }
        const float gate = (br == 0) ? gate0 : (br == 1) ? gate1 : gate2;
#pragma unroll 1
        for (int i = 0; i < n; ++i) {
            if (br == 1 || i + 1 < n) asm volatile("s_waitcnt vmcnt(2)" ::: "memory"); else asm volatile("s_waitcnt vmcnt(0)" ::: "memory");
            __builtin_amdgcn_s_barrier(); asm volatile("" ::: "memory");
            { const int s2 = (slot == 0) ? 2 : slot - 1;
              if (br == 0) { if (i + 2 < n) { const int t = pop_bit(mD); k_dma(Kg, pitch, t * 64, lds + OFF_K + s2 * 8192, wid, lane); v_dma(Vg, pitch, t * 64, lds + OFF_V + s2 * 8192, wid, lane); } }
              else if (mDs | mDw) DMA_NEXT12(s2); }
            const int tcur = pop_bit(mC);
            const LAS char* Ks = lds + OFF_K + slot * 8192; const LAS char* Vs = lds + OFF_V + slot * 8192;
            bf16x8 ka[8];
#pragma unroll
            for (int d0 = 0; d0 < 4; ++d0) {
                ka[2 * d0] = *(const LAS bf16x8*)(Ks + (2 * d0 + hi) * 1024 + r32 * 16);
                ka[2 * d0 + 1] = *(const LAS bf16x8*)(Ks + (2 * d0 + hi) * 1024 + 512 + r32 * 16);
            }
            __builtin_amdgcn_sched_barrier(0);
            f32x16 c0 = negm, c1 = negm;
#pragma unroll
            for (int d0 = 0; d0 < 4; ++d0) {
                c0 = __builtin_amdgcn_mfma_f32_32x32x16_bf16(ka[2 * d0], qr[d0], c0, 0, 0, 0);
                c1 = __builtin_amdgcn_mfma_f32_32x32x16_bf16(ka[2 * d0 + 1], qr[d0], c1, 0, 0, 0);
            }
            bf16x8 vf[8];
#pragma unroll
            for (int f = 0; f < 8; ++f) {
                const s16x4 lo = vtr(Vs + vbase + f * 1024), hi4 = vtr(Vs + vbase + f * 1024 + 512);
                vf[f] = (bf16x8){lo[0], lo[1], lo[2], lo[3], hi4[0], hi4[1], hi4[2], hi4[3]};
            }
            __builtin_amdgcn_sched_barrier(0);
            int lim_hi, lim_lo = -1000000;
            if (br == 0) lim_hi = jmax - tcur * 64;
            else { lim_hi = tq - tcur * 64; if (br == 1) { if (!((mysel >> tcur) & 1u)) lim_hi = -1; } else lim_lo = lim_hi - 512; }
            const bool interior = __all((lim_hi >= 63) && (lim_lo < 0));
            if (!interior) {
                if (__all(((lim_hi >= 63) || (lim_hi < 0)) && (lim_lo < 0))) {
                    const bool vis = lim_hi >= 63;
#pragma unroll
                    for (int r = 0; r < 16; ++r) { c0[r] = vis ? c0[r] : -INFINITY; c1[r] = vis ? c1[r] : -INFINITY; }
                } else {
                    const int lh = lim_hi - 4 * hi, ll = lim_lo - 4 * hi;
                    if (__all(lim_lo < 0)) {
#pragma unroll
                        for (int r = 0; r < 16; ++r) { const int c = (r & 3) + 8 * (r >> 2); c0[r] = (c <= lh) ? c0[r] : -INFINITY; c1[r] = (c + 32 <= lh) ? c1[r] : -INFINITY; }
                    } else if (__all(lim_hi >= 63)) {
#pragma unroll
                        for (int r = 0; r < 16; ++r) { const int c = (r & 3) + 8 * (r >> 2); c0[r] = (c > ll) ? c0[r] : -INFINITY; c1[r] = (c + 32 > ll) ? c1[r] : -INFINITY; }
                    } else {
#pragma unroll
                        for (int r = 0; r < 16; ++r) {
                            const int c = (r & 3) + 8 * (r >> 2);
                            c0[r] = (c <= lh && c > ll) ? c0[r] : -INFINITY;
                            c1[r] = (c + 32 <= lh && c + 32 > ll) ? c1[r] : -INFINITY;
                        }
                    }
                }
            }
            int mi = (int)0x80000000;
#pragma unroll
            for (int r = 0; r < 16; ++r) { const float x0 = c0[r], x1 = c1[r]; mi = imax3(mi, __float_as_int(x0), __float_as_int(x1)); }
            if (i == 0 || __any(mi > 0x41000000)) {
                float mx = -INFINITY;
#pragma unroll
                for (int r = 0; r < 16; ++r) mx = fmaxf(mx, fmaxf(c0[r], c1[r]));
                mx = hmax(mx);
                const float d = (i == 0) ? ((mx == -INFINITY) ? 0.f : mx) : ((mx > 8.f) ? mx : 0.f);
                m_run += d;
#pragma unroll
                for (int r = 0; r < 16; ++r) { c0[r] -= d; c1[r] -= d; negm[r] = -m_run; }
                if (i > 0) {
                    if (hi == 0) wsf[r32] = ex2(-d);
                    asm volatile("s_waitcnt lgkmcnt(0)" ::: "memory");
                    f32x16 fv;
#pragma unroll
                    for (int r = 0; r < 16; ++r) fv[r] = wsf[crow(r, hi)];
                    o[0] *= fv; o[1] *= fv; lacc *= fv;
                    asm volatile("s_waitcnt lgkmcnt(0)" ::: "memory");
                }
            }
#define SB() __builtin_amdgcn_sched_barrier(0)
#define MF_L(P) lacc = __builtin_amdgcn_mfma_f32_32x32x16_bf16(__builtin_bit_cast(bf16x8, P), ones, lacc, 0, 0, 0)
#define MF_O(dt, P, f) o[dt] = __builtin_amdgcn_mfma_f32_32x32x16_bf16(__builtin_bit_cast(bf16x8, P), vf[f], o[dt], 0, 0, 0)
#pragma unroll
            for (int r = 0; r < 16; ++r) c0[r] = ex2(c0[r]);
            const u32x4 pw0 = (u32x4){cvtpk(c0[0], c0[1]), cvtpk(c0[2], c0[3]), cvtpk(c0[4], c0[5]), cvtpk(c0[6], c0[7])};
            const u32x4 pw1 = (u32x4){cvtpk(c0[8], c0[9]), cvtpk(c0[10], c0[11]), cvtpk(c0[12], c0[13]), cvtpk(c0[14], c0[15])};
            u32x4 pw2, pw3;
            SB(); MF_L(pw0); SB(); c1[0] = ex2(c1[0]); c1[1] = ex2(c1[1]); c1[2] = ex2(c1[2]);
            SB(); MF_O(0, pw0, 0); SB(); c1[3] = ex2(c1[3]); c1[4] = ex2(c1[4]); c1[5] = ex2(c1[5]);
            SB(); MF_O(1, pw0, 4); SB(); c1[6] = ex2(c1[6]); c1[7] = ex2(c1[7]); pw2.x = cvtpk(c1[0], c1[1]); pw2.y = cvtpk(c1[2], c1[3]);
            SB(); MF_L(pw1); SB(); pw2.z = cvtpk(c1[4], c1[5]); pw2.w = cvtpk(c1[6], c1[7]); c1[8] = ex2(c1[8]); c1[9] = ex2(c1[9]);
            SB(); MF_O(0, pw1, 1); SB(); c1[10] = ex2(c1[10]); c1[11] = ex2(c1[11]); c1[12] = ex2(c1[12]);
            SB(); MF_O(1, pw1, 5); SB(); c1[13] = ex2(c1[13]); c1[14] = ex2(c1[14]); c1[15] = ex2(c1[15]);
            pw3 = (u32x4){cvtpk(c1[8], c1[9]), cvtpk(c1[10], c1[11]), cvtpk(c1[12], c1[13]), cvtpk(c1[14], c1[15])};
            SB(); MF_L(pw2); MF_O(0, pw2, 2); MF_O(1, pw2, 6); MF_L(pw3); MF_O(0, pw3, 3); MF_O(1, pw3, 7);
#undef SB
#undef MF_L
#undef MF_O
            slot = (slot == 2) ? 0 : slot + 1;
        }
        asm volatile("s_waitcnt lgkmcnt(0)" ::: "memory");
        if (br == 0) {
            int tid_o = C.tid; asm volatile("" : "+v"(tid_o));
            const int tid = tid_o, lane = tid & 63, r32 = lane & 31, hi = lane >> 5;
            if (qb < 16) {
                LDS_BAR();
                if (tid <= 64) selm[tid] = (2u << qb) - 1u;
            } else {
#pragma unroll
                for (int r = 0; r < 16; ++r) wsf[crow(r, hi)] = lacc[r];
                asm volatile("s_waitcnt lgkmcnt(0)" ::: "memory");
                const float lrow = wsf[r32];
                asm volatile("s_waitcnt lgkmcnt(0)" ::: "memory");
                const float invl = lrow > 0.f ? 1.0f / lrow : 0.f;
#pragma unroll 1
                for (int t2 = 0; t2 < 2; ++t2) {
                    f32x16 p0, p1; qk(p0, p1, lds + OFF_K + t2 * 8192, qr, r32, hi);
                    const int lim_hi = jmax - t2 * 64;
#pragma unroll
                    for (int r = 0; r < 16; ++r) {
                        const int c = crow(r, hi);
                        p0[r] = (c <= lim_hi) ? ex2(p0[r] - m_run) * invl : 0.f;
                        p1[r] = (c + 32 <= lim_hi) ? ex2(p1[r] - m_run) * invl : 0.f;
                    }
#pragma unroll 1
                    for (int gg = 0; gg < 4; ++gg) {
                        if (g == gg) {
#pragma unroll
                            for (int r = 0; r < 16; ++r) {
                                const int idx = (32 * th + r32) * IMP_LD + t2 * 64 + crow(r, hi);
                                if (gg == 0) { imp[idx] = p0[r]; imp[idx + 32] = p1[r]; }
                                else { imp[idx] += p0[r]; imp[idx + 32] += p1[r]; }
                            }
                        }
                        LDS_BAR();
                    }
                }
                LAS float* sc = (LAS float*)(lds + OFF_SC);
                if (tid == 0) selm[64] = 0u;
                const int tl = tid >> 3, sub = tid & 7;
                float my[4];
#pragma unroll
                for (int k = 0; k < 4; ++k) {
                    const int sx = sub * 4 + k; float v = 0.f;
#pragma unroll
                    for (int j = 4 * sx - 1; j <= 4 * sx + 3; ++j) if (j >= 0 && j <= 126) v += imp[tl * IMP_LD + j];
                    if (sx > qb) v = -1e4f; else if (sx == 0 || sx == qb || sx == qb - 1) v += 1e4f;
                    my[k] = v; sc[tl * SC_LD + sx] = v;
                }
                LDS_BAR();
                unsigned bits = 0u;
#pragma unroll
                for (int k = 0; k < 4; ++k) {
                    const int sx = sub * 4 + k; int rank = 0;
                    for (int s2 = 0; s2 < 32; ++s2) { const float ov = sc[tl * SC_LD + s2]; rank += ((ov > my[k]) || (ov == my[k] && s2 < sx)) ? 1 : 0; }
                    if (rank < 16 && sx <= qb) bits |= 1u << sx;
                }
                bits |= __shfl_xor(bits, 1); bits |= __shfl_xor(bits, 2); bits |= __shfl_xor(bits, 4);
                if (sub == 0) { selm[tl] = bits; atomicOr((unsigned*)&selm[64], bits); }
            }
            LDS_BAR();
            mysel = selm[32 * th + r32]; usel = selm[64];
        }
        {
        int lane_o = C.lane; asm volatile("" : "+v"(lane_o));
        const int r32 = lane_o & 31, hi = lane_o >> 5;
        if (hi == 0) wsf[r32] = gate;
        asm volatile("s_waitcnt lgkmcnt(0)" ::: "memory");
        if (br == 0) {
#pragma unroll
            for (int r = 0; r < 16; ++r) { const float f = wsf[crow(r, hi)] * ((lacc[r] > 0.f) ? __builtin_amdgcn_rcpf(lacc[r]) : 0.f); stg[crow(r, hi) * 64 + r32] = o[0][r] * f; stg[crow(r, hi) * 64 + 32 + r32] = o[1][r] * f; }
        } else {
#pragma unroll
            for (int r = 0; r < 16; ++r) { const float f = wsf[crow(r, hi)] * ((lacc[r] > 0.f) ? __builtin_amdgcn_rcpf(lacc[r]) : 0.f); stg[crow(r, hi) * 64 + r32] += o[0][r] * f; stg[crow(r, hi) * 64 + 32 + r32] += o[1][r] * f; }
        }
        asm volatile("s_waitcnt lgkmcnt(0)" ::: "memory");
        }
    }
#undef DMA_NEXT12
    {
        int le = lane; asm volatile("" : "+v"(le));
#pragma unroll
        for (int k = 0; k < 4; ++k) {
            const int row = k * 8 + (le >> 3), ch = le & 7;
            const size_t m = (size_t)b * SEQ + t0 + 32 * th + row;
            const f32x4 x0 = *(const LAS f32x4*)(stg + row * 64 + ch * 8), x1 = *(const LAS f32x4*)(stg + row * 64 + ch * 8 + 4);
            const u32x4 gw4 = *(const u32x4*)(PJ + m * NP + C_GN + h * 64 + ch * 8);
            float gf[8]; unpack8(gw4, gf);
            u32x4 w; w.x = cvtpk(x0.x * fsilu(gf[0]), x0.y * fsilu(gf[1])); w.y = cvtpk(x0.z * fsilu(gf[2]), x0.w * fsilu(gf[3]));
            w.z = cvtpk(x1.x * fsilu(gf[4]), x1.y * fsilu(gf[5])); w.w = cvtpk(x1.z * fsilu(gf[6]), x1.w * fsilu(gf[7]));
            *(u32x4*)(C.MIX + m * DM + 512 + h * 64 + ch * 8) = w;
        }
        asm volatile("s_waitcnt lgkmcnt(0)" ::: "memory");
    }
    LDS_BAR();
}

constexpr int SLD = 1040;
__device__ __forceinline__ void softmax_row(LAS float* s, int n, int lane) {
    float mx = -INFINITY;
    for (int j = lane; j < n; j += 64) mx = fmaxf(mx, s[j]);
    mx = wave_max_dpp(mx);
    float sm = 0.f;
    for (int j = lane; j < n; j += 64) { const float e = __builtin_amdgcn_exp2f(s[j] - mx); s[j] = e; sm += e; }
    sm = wave_sum_dpp(sm);
    const float inv = 1.0f / sm;
    for (int j = lane; j < n; j += 64) s[j] *= inv;
    asm volatile("s_waitcnt lgkmcnt(0)" ::: "memory");
}
__device__ __forceinline__ void load_key_f32(const float* p, float (&kf)[64]) {
#pragma unroll
    for (int i = 0; i < 16; ++i) { const f32x4 q = *(const f32x4*)(p + 4 * i); kf[4 * i] = q.x; kf[4 * i + 1] = q.y; kf[4 * i + 2] = q.z; kf[4 * i + 3] = q.w; }
}
__device__ __forceinline__ void load_key_bf16(const bf16_t* p, float (&kf)[64]) {
#pragma unroll
    for (int i = 0; i < 8; ++i) { const u32x4 q = *(const u32x4*)(p + 8 * i); unpack8(q, &kf[8 * i]); }
}
__device__ __forceinline__ float dot64(const float (&kf)[64], const LAS float* q) {
    float a0 = 0.f, a1 = 0.f;
#pragma unroll
    for (int i = 0; i < 16; ++i) { const f32x4 v = *(const LAS f32x4*)(q + 4 * i); a0 += kf[4 * i] * v.x + kf[4 * i + 2] * v.z; a1 += kf[4 * i + 1] * v.y + kf[4 * i + 3] * v.w; }
    return a0 + a1;
}
__device__ __forceinline__ f32x4 ld4_bf16(const bf16_t* p) { const u32x2 w = *(const u32x2*)p; return (f32x4){bflo(w.x), bfhi(w.x), bflo(w.y), bfhi(w.y)}; }
template <int KPS, class VL>
__device__ __forceinline__ void pv_valu(const LAS float* S, int nkeys, const VL& vload, LAS float* part, LAS float* outp, int tid) {
    const int ksub = tid >> 4, d4 = tid & 15;
    f32x4 acc[4];
#pragma unroll
    for (int g = 0; g < 4; ++g) acc[g] = (f32x4){0.f, 0.f, 0.f, 0.f};
#pragma unroll 16
    for (int i = 0; i < KPS; ++i) {
        const int kk = ksub * KPS + i;
        if (kk < nkeys) {
            const f32x4 v = vload(kk, d4);
#pragma unroll
            for (int g = 0; g < 4; ++g) acc[g] += v * S[g * SLD + kk];
        }
    }
#pragma unroll
    for (int g = 0; g < 4; ++g) *(LAS f32x4*)(part + (ksub * 4 + g) * 64 + d4 * 4) = acc[g];
    __syncthreads();
    if (tid < 256) { float r = 0.f;
#pragma unroll 8
        for (int k2 = 0; k2 < 32; ++k2) r += part[(k2 * 4 + (tid >> 6)) * 64 + (tid & 63)];
        outp[tid] = r; }
    __syncthreads();
}
__device__ __forceinline__ float dot64_bf16(const u32x4 (&k)[8], const LAS float* q) {
    float a0 = 0.f, a1 = 0.f;
#pragma unroll
    for (int i = 0; i < 8; ++i) {
        const f32x4 q0 = *(const LAS f32x4*)(q + 8 * i), q1 = *(const LAS f32x4*)(q + 8 * i + 4);
        a0 += bflo(k[i].x) * q0.x + bflo(k[i].y) * q0.z + bflo(k[i].z) * q1.x + bflo(k[i].w) * q1.z;
        a1 += bfhi(k[i].x) * q0.y + bfhi(k[i].y) * q0.w + bfhi(k[i].z) * q1.y + bfhi(k[i].w) * q1.w;
    }
    return a0 + a1;
}
__device__ __forceinline__ float dot64_f32(const f32x4 (&k)[16], const LAS float* q) {
    float a0 = 0.f, a1 = 0.f;
#pragma unroll
    for (int i = 0; i < 16; ++i) { const f32x4 v = *(const LAS f32x4*)(q + 4 * i); a0 += k[i].x * v.x + k[i].z * v.z; a1 += k[i].y * v.y + k[i].w * v.w; }
    return a0 + a1;
}
constexpr int WLD = 576;
__device__ __forceinline__ void attn_sample_unit(const Ctx& C, LAS char* lds, int b, int kvh, int t) {
    int tid_o = C.tid; asm volatile("" : "+v"(tid_o));
    const int tid = tid_o, lane = tid & 63, wid = __builtin_amdgcn_readfirstlane(tid >> 6);
    LAS float* Qs = (LAS float*)lds;
    LAS float* S = (LAS float*)(lds + 1024);
    LAS float* W = (LAS float*)(lds + 17664);
    LAS float* scS = (LAS float*)(lds + 26880);
    LAS int* idxS = (LAS int*)(lds + 27920);
    LAS int* rowidx = (LAS int*)(lds + 27984);
    LAS float* part = (LAS float*)(lds + 32256);
    LAS float* part2 = (LAS float*)(lds + 65024);
    LAS float* outS = (LAS float*)(lds + 97792);
    const int msb = MP + b * 4; const size_t m = (size_t)(msb + t);
    const bf16_t* PJ = C.PJ;
    __syncthreads();
    if (tid < 256) Qs[tid] = bf2f(PJ[m * NP + C_Q + (kvh * 4 + (tid >> 6)) * 64 + (tid & 63)]);
    if (tid < 4) S[tid * SLD + 1023] = -INFINITY;
    {
        u32x4 c0[8], c1[8];
        const bf16_t* kp = C.CMPK_S + ((size_t)(b * 2 + kvh) * 1024) * 64;
        const int j1 = (tid + 512 < 1023) ? tid + 512 : 1022;
#pragma unroll
        for (int i = 0; i < 8; ++i) { c0[i] = *(const u32x4*)(kp + (size_t)tid * 64 + 8 * i); c1[i] = *(const u32x4*)(kp + (size_t)j1 * 64 + 8 * i); }
        __syncthreads();
#pragma unroll 1
        for (int g = 0; g < 4; ++g) {
            S[g * SLD + tid] = dot64_bf16(c0, Qs + g * 64);
            if (tid + 512 < 1023) S[g * SLD + tid + 512] = dot64_bf16(c1, Qs + g * 64);
        }
    }
    {
        f32x4 wk[16];
        const float* wp = C.win + ((size_t)(b * 512 + tid) * 2 + 0) * 128 + kvh * 64;
#pragma unroll
        for (int i = 0; i < 16; ++i) wk[i] = *(const f32x4*)(wp + 4 * i);
#pragma unroll 1
        for (int g = 0; g < 4; ++g) { const float a = dot64_f32(wk, Qs + g * 64); W[g * WLD + tid] = (tid > t) ? a : -INFINITY; }
        if (tid < 64) {
            const int i = 512 + tid;
            if (tid < 4) {
                float kf[64]; load_key_bf16(PJ + (size_t)(msb + tid) * NP + C_KV + 4 * 128 + kvh * 64, kf);
#pragma unroll 1
                for (int g = 0; g < 4; ++g) { const float a = dot64(kf, Qs + g * 64); W[g * WLD + i] = (tid <= t) ? a : -INFINITY; }
            } else {
#pragma unroll
                for (int g = 0; g < 4; ++g) W[g * WLD + i] = -INFINITY;
            }
        }
    }
    __syncthreads();
    if (wid < 4) softmax_row(S + wid * SLD, 1024, lane); else softmax_row(W + (wid - 4) * WLD, WLD, lane);
    __syncthreads();
    if (tid < 257) {
        const int s = tid; float v = 0.f;
        for (int j = 4 * s - 1; j <= 4 * s + 3; ++j) if (j >= 0 && j < 1023) v += ((S[j] + S[SLD + j]) + S[2 * SLD + j]) + S[3 * SLD + j];
        if (s == 0 || s == 255 || s == 256) v += 1e4f;
        scS[s] = v;
    }
    {
        const int ksub = tid >> 4, d4 = tid & 15;
        const bf16_t* vb = C.CMPV_S + (size_t)(b * 2 + kvh) * 1024 * 64 + d4 * 4;
        const float* wv = C.win + ((size_t)(b * 512) * 2 + 1) * 128 + kvh * 64 + d4 * 4;
        f32x4 ac[4], aw[4];
#pragma unroll
        for (int g = 0; g < 4; ++g) { ac[g] = (f32x4){0.f, 0.f, 0.f, 0.f}; aw[g] = ac[g]; }
#pragma unroll 8
        for (int i = 0; i < 32; ++i) {
            const int kk = ksub * 32 + i; const f32x4 v = ld4_bf16(vb + (size_t)kk * 64);
#pragma unroll
            for (int g = 0; g < 4; ++g) ac[g] += v * S[g * SLD + kk];
        }
#pragma unroll 6
        for (int i = 0; i < 17; ++i) {
            const int kk = ksub * 17 + i;
            if (kk < 516) {
                const f32x4 v = (kk < 512) ? *(const f32x4*)(wv + (size_t)kk * 256) : ld4_bf16(PJ + (size_t)(msb + kk - 512) * NP + C_KV + 5 * 128 + kvh * 64 + d4 * 4);
#pragma unroll
                for (int g = 0; g < 4; ++g) aw[g] += v * W[g * WLD + kk];
            }
        }
#pragma unroll
        for (int g = 0; g < 4; ++g) { *(LAS f32x4*)(part + (ksub * 4 + g) * 64 + d4 * 4) = ac[g]; *(LAS f32x4*)(part2 + (ksub * 4 + g) * 64 + d4 * 4) = aw[g]; }
    }
    __syncthreads();
    {
        const LAS float* pp = (tid < 256) ? part : part2; const int q = tid & 255; float r = 0.f;
#pragma unroll 8
        for (int k2 = 0; k2 < 32; ++k2) r += pp[(k2 * 4 + (q >> 6)) * 64 + (q & 63)];
        outS[(tid < 256 ? 0 : 512) + q] = r;
    }
    if (tid < 257) {
        const float mine = scS[tid]; int rank = 0;
        for (int s2 = 0; s2 < 257; ++s2) { const float ov = scS[s2]; rank += ((ov > mine) || (ov == mine && s2 < tid)) ? 1 : 0; }
        if (rank < 16) idxS[rank] = tid;
    }
    __syncthreads();
    for (int kk = tid; kk < 1024; kk += 512) {
        const int blk = idxS[kk >> 6], r = kk & 63; int ri;
        if (blk < 256) { const int pg = C.pt[b * 128 + (blk >> 1)]; ri = pg * 128 + (blk & 1) * 64 + r; } else ri = -1 - r;
        rowidx[kk] = ri;
    }
    __syncthreads();
#pragma unroll 1
    for (int kk = tid; kk < 1024; kk += 512) {
        const int ri = rowidx[kk]; float kf[64]; bool valid = true;
        if (ri >= 0) load_key_f32(C.cache + (size_t)ri * 512 + 2 * 128 + kvh * 64, kf);
        else {
            const int r = -1 - ri; valid = (r <= t);
            if (r < 4) load_key_bf16(PJ + (size_t)(msb + r) * NP + C_KV + 2 * 128 + kvh * 64, kf);
            else {
#pragma unroll
                for (int d = 0; d < 64; ++d) kf[d] = 0.f;
            }
        }
#pragma unroll 1
        for (int g = 0; g < 4; ++g) { const float a = dot64(kf, Qs + g * 64); S[g * SLD + kk] = valid ? a : -INFINITY; }
    }
    __syncthreads();
    if (wid < 4) softmax_row(S + wid * SLD, 1024, lane);
    __syncthreads();
    {
        auto vl = [&](int kk, int d4) {
            const int ri = rowidx[kk];
            if (ri >= 0) return *(const f32x4*)(C.cache + (size_t)ri * 512 + 3 * 128 + kvh * 64 + d4 * 4);
            const int r = -1 - ri;
            if (r < 4) return ld4_bf16(PJ + (size_t)(msb + r) * NP + C_KV + 3 * 128 + kvh * 64 + d4 * 4);
            return (f32x4){0.f, 0.f, 0.f, 0.f};
        };
        pv_valu<32>(S, 1024, vl, part, outS + 256, tid);
    }
    if (tid < 256) {
        const int g = tid >> 6, d = tid & 63, h = kvh * 4 + g;
        const float g0 = sigm(bf2f(PJ[m * NP + C_GL + h])), g1 = sigm(bf2f(PJ[m * NP + C_GL + 8 + h])), g2 = sigm(bf2f(PJ[m * NP + C_GL + 16 + h]));
        const float o = g0 * outS[tid] + g1 * outS[256 + tid] + g2 * outS[512 + tid];
        const float gn = bf2f(PJ[m * NP + C_GN + h * 64 + d]);
        C.MIX[m * DM + 512 + h * 64 + d] = f2bf(o * silu(gn));
    }
    __syncthreads();
}
}

__device__ __forceinline__ int cmp_streamer_index(int bid) { const int g = bid >> 3; return ((g & 1) && g >= 13 && g <= 27) ? ((g - 13) >> 1) * 8 + (bid & 7) : -1; }
__device__ __forceinline__ int cmp_streamer_count(int G) { int n = 0; for (int g = 13; g <= 27; g += 2) { const int r = G - g * 8; n += r <= 0 ? 0 : (r < 8 ? r : 8); } return n; }
__device__ __forceinline__ void p4_attention(const Ctx& C, LAS unsigned char* lds) {
    unsigned* qctr = (unsigned*)(C.ws + WS_CTL) + 64;
    volatile LAS unsigned* slot = (volatile LAS unsigned*)(lds + MISC_OFF) + 16;
    int nxt = 0;
#define Q_ISSUE() do { if (C.tid == 0) nxt = (int)__hip_atomic_fetch_add(qctr, 1u, __ATOMIC_RELAXED, __HIP_MEMORY_SCOPE_AGENT); } while (0)
#define Q_TAKE(dst) do { LDS_BAR(); if (C.tid == 0) slot[0] = (unsigned)nxt; LDS_BAR(); dst = (int)slot[0]; } while (0)
    int id;
    unsigned* sdone = (unsigned*)(C.ws + WS_CTL) + 192;
    if (C.bid < 64) {
        rk::bc_state_pass(C, (LAS char*)lds, C.bid * 2 + (C.wid >> 2));
        asm volatile("s_waitcnt vmcnt(0)" ::: "memory");
        __syncthreads();
        if (C.tid == 0) { __builtin_amdgcn_fence(__ATOMIC_RELEASE, "agent"); asm volatile("s_waitcnt vmcnt(0)" ::: "memory"); __hip_atomic_fetch_add(sdone, 1u, __ATOMIC_RELAXED, __HIP_MEMORY_SCOPE_AGENT); }
    } else if (C.bid < 96) rwkv_sample_unit(C, C.bid - 64, C.wid, (LAS float*)(lds + C.wid * 8704));
    __syncthreads();
    constexpr int RP = 1 + ((DUPMASK >> 12) & 1), RO = 1 + ((DUPMASK >> 14) & 1);
    constexpr int NQ_P = 1024 * RP, NQ_O = 1024 * RO;
    if (cmp_streamer_index(C.bid) >= 0) {
        unsigned* qc2 = (unsigned*)(C.ws + WS_CTL) + 128;
        load_cmp_consts(C, lds);
        CmpW W; load_cmp_w(C, W);
        RowsSample R{C.cache, C.pt};
        for (int i = cmp_streamer_index(C.bid) * 512 + C.tid; i < DECB * 2 * 64; i += cmp_streamer_count(C.G) * 512) { const int bk = i >> 6, d = i & 63; C.CMPK_S[((size_t)bk * 1024 + 1023) * 64 + d] = 0; C.CMPV_S[((size_t)bk * 1024 + 1023) * 64 + d] = 0; }
#pragma unroll 1
        for (;;) {
            __syncthreads(); if (C.tid == 0) slot[0] = __hip_atomic_fetch_add(qc2, 1u, __ATOMIC_RELAXED, __HIP_MEMORY_SCOPE_AGENT); __syncthreads();
            const int q = (int)slot[0]; if (q >= 1024) break;
            const int b = q >> 5, j0 = (q & 31) * 32; const int nj = (1023 - j0) < 32 ? (1023 - j0) : 32;
            compress_item(R, b, j0, nj, lds, C.CMPK_S, C.CMPV_S, 1024, C.tid, C.lane, C.wid, W);
        }
        __builtin_amdgcn_s_waitcnt(0x0F70);
        __syncthreads();
        if (C.tid == 0) { __builtin_amdgcn_fence(__ATOMIC_RELEASE, "agent"); asm volatile("s_waitcnt vmcnt(0)" ::: "memory"); __hip_atomic_fetch_add((unsigned*)(C.ws + WS_CTL) + 224, 1u, __ATOMIC_RELAXED, __HIP_MEMORY_SCOPE_AGENT); }
    }
    Q_ISSUE(); Q_TAKE(id);
#pragma unroll 1
    while (id < NQ_P) { Q_ISSUE(); const int q = id & 1023, qb = 31 - (q >> 5), bk = q & 31; att::attn_prompt_unit(C, (LAS char*)lds, bk >> 1, bk & 1, qb); Q_TAKE(id); }
    if (id < NQ_P + NQ_O) {
        if (C.tid == 0) {
            unsigned sp = 0;
            while (__hip_atomic_load(sdone, __ATOMIC_RELAXED, __HIP_MEMORY_SCOPE_AGENT) < 64u) { __builtin_amdgcn_s_sleep(4); if (++sp > (1u << 22)) break; }
            __builtin_amdgcn_fence(__ATOMIC_ACQUIRE, "agent");
            asm volatile("s_waitcnt vmcnt(0)" ::: "memory");
        }
        __syncthreads();
    }
    LAS float* cst = (LAS float*)lds;
    if (id < NQ_P + NQ_O) {
        for (int i = C.tid; i < 512; i += 512) { cst[i] = C.mu[C_V + i]; cst[512 + i] = C.gn_w[i]; cst[1024 + i] = C.gn_b[i]; }
        __syncthreads();
    }
#pragma unroll 1
    while (id < NQ_P + NQ_O) { Q_ISSUE(); const int p = (id - NQ_P) & 1023; rk::bc_output_wave(C, p >> 3, (p & 7) * 4 + (C.wid >> 1), C.wid & 1, cst); Q_TAKE(id); }
#undef Q_ISSUE
#undef Q_TAKE
}

__device__ __forceinline__ void p5_sample_attention(const Ctx& C, LAS unsigned char* lds) {
    constexpr int RS = 1 + ((DUPMASK >> 13) & 1);
    __syncthreads();
    if (C.tid == 0) {
        unsigned* cdone = (unsigned*)(C.ws + WS_CTL) + 224; unsigned sp = 0;
        while (__hip_atomic_load(cdone, __ATOMIC_RELAXED, __HIP_MEMORY_SCOPE_AGENT) < (unsigned)cmp_streamer_count(C.G)) { __builtin_amdgcn_s_sleep(4); if (++sp > (1u << 22)) break; }
        __builtin_amdgcn_fence(__ATOMIC_ACQUIRE, "agent");
        asm volatile("s_waitcnt vmcnt(0)" ::: "memory");
    }
    __syncthreads();
    for (int p = C.bid; p < 256 * RS; p += C.G) { const int u = p & 255; att::attn_sample_unit(C, (LAS char*)lds, u >> 3, (u >> 2) & 1, u & 3); }
}

__device__ __forceinline__ void p6_final_norm(const Ctx& C) {
    f32x4 gq[4];
#pragma unroll
    for (int j = 0; j < 4; ++j) gq[j] = *(const f32x4*)(C.final_g + 4 * (C.lane + 64 * j));
    const bf16_t* yb = (const bf16_t*)(C.ws + WS_YB);
    for (int m4 = C.gw * 4; m4 < MP; m4 += C.NGW * 4) {
        f32x4 v[4][4]; float rs[4];
#pragma unroll
        for (int q = 0; q < 4; ++q)
#pragma unroll
            for (int j = 0; j < 4; ++j) { const u32x2 w = *(const u32x2*)(yb + (size_t)(m4 + q) * DM + 4 * (C.lane + 64 * j)); v[q][j] = (f32x4){bflo(w.x), bfhi(w.x), bflo(w.y), bfhi(w.y)}; }
#pragma unroll
        for (int q = 0; q < 4; ++q) {
            float a = 0.f;
#pragma unroll
            for (int j = 0; j < 4; ++j) a += (v[q][j].x * v[q][j].x + v[q][j].y * v[q][j].y) + (v[q][j].z * v[q][j].z + v[q][j].w * v[q][j].w);
            rs[q] = 1.0f / sqrtf(wave_sum_dpp(a) * (1.0f / DM) + 1e-6f);
        }
#pragma unroll
        for (int q = 0; q < 4; ++q)
#pragma unroll
            for (int j = 0; j < 4; ++j) __builtin_nontemporal_store(v[q][j] * rs[q] * gq[j], (f32x4*)(C.out + (size_t)(m4 + q) * DM + 4 * (C.lane + 64 * j)));
    }
    for (int m = MP + C.gw; m < MTOT; m += C.NGW) {
        float* y = C.out + (size_t)m * DM; f32x4 v[4]; float a = 0.f;
#pragma unroll
        for (int j = 0; j < 4; ++j) { v[j] = *(const f32x4*)(y + 4 * (C.lane + 64 * j)); a += (v[j].x * v[j].x + v[j].y * v[j].y) + (v[j].z * v[j].z + v[j].w * v[j].w); }
        const float rs = 1.0f / sqrtf(wave_sum_dpp(a) * (1.0f / DM) + 1e-6f);
#pragma unroll
        for (int j = 0; j < 4; ++j) *(f32x4*)(y + 4 * (C.lane + 64 * j)) = v[j] * rs * gq[j];
    }
}

struct Args { const void* in[23]; float* out; unsigned char* ws; int ph_lo, ph_hi; };
constexpr int N_PHASES = 8;
__global__ void __launch_bounds__(512, 2) fwd(Args args) {
    extern __shared__ __attribute__((aligned(16))) unsigned char lds_raw[];
    LAS unsigned char* lds = (LAS unsigned char*)lds_raw;
    Ctx C;
    C.xp = (const float*)args.in[0]; C.xs = (const float*)args.in[1]; C.cache = (const float*)args.in[2]; C.win = (const float*)args.in[3];
    C.swkv = (const float*)args.in[4]; C.sshift = (const float*)args.in[5]; C.pt = (const int*)args.in[6];
    C.norm_g = (const float*)args.in[7]; C.w_in = (const float*)args.in[8]; C.mu = (const float*)args.in[9]; C.w0 = (const float*)args.in[10];
    C.wdu = (const float*)args.in[11]; C.a0 = (const float*)args.in[12]; C.wau = (const float*)args.in[13]; C.k_k = (const float*)args.in[14];
    C.k_a = (const float*)args.in[15]; C.r_k = (const float*)args.in[16]; C.gn_w = (const float*)args.in[17]; C.gn_b = (const float*)args.in[18];
    C.wpos = (const float*)args.in[19]; C.wmix = (const float*)args.in[20]; C.w_out = (const float*)args.in[21]; C.final_g = (const float*)args.in[22];
    C.out = args.out; C.ws = args.ws;
    unsigned char* ws = args.ws;
    C.WinT = (bf16_t*)(ws + WS_WINT); C.WoutT = (bf16_t*)(ws + WS_WOUT); C.XB = (bf16_t*)(ws + WS_XB); C.MIX = (bf16_t*)(ws + WS_MIX); C.PJ = (bf16_t*)(ws + WS_PJ);
    C.CMPK_P = (bf16_t*)(ws + WS_CMPK_P); C.CMPV_P = (bf16_t*)(ws + WS_CMPV_P); C.CMPK_S = (bf16_t*)(ws + WS_CMPK_S); C.CMPV_S = (bf16_t*)(ws + WS_CMPV_S);
    C.RS = (float*)(ws + WS_RS); C.BONUS = (float*)(ws + WS_BONUS); C.WduT = (bf16_t*)(ws + WS_WDUT); C.WauT = (bf16_t*)(ws + WS_WAUT); C.CHK = ws + WS_CHK; C.S0R = ws + WS_S0;
    C.RWkk = (float*)(ws + WS_RW); C.RWw = (float*)(ws + WS_RW + RW_STRIDE); C.RWb = (float*)(ws + WS_RW + 2 * RW_STRIDE);
    C.RWk = (float*)(ws + WS_RW + 3 * RW_STRIDE); C.RWr = (float*)(ws + WS_RW + 4 * RW_STRIDE); C.RWv = (float*)(ws + WS_RW + 5 * RW_STRIDE);
    C.tid = threadIdx.x; C.lane = C.tid & 63; C.wid = __builtin_amdgcn_readfirstlane(C.tid >> 6); C.bid = blockIdx.x; C.G = gridDim.x;
    C.gw = C.bid * 8 + C.wid; C.NGW = C.G * 8;

    volatile LAS unsigned* MISC = (volatile LAS unsigned*)(lds + MISC_OFF);
    if (C.tid < 64) MISC[C.tid] = 0u;
    __syncthreads();
    const int lo = args.ph_lo, hi = args.ph_hi;
    const bool one = (hi - lo) > 1;
    XcdBarrier bar; bar.bar = (unsigned*)(ws + WS_CTL) + 1024; bar.x = 0; bar.st = nullptr;
    if (one) bar = xcd_barrier_post((unsigned*)(ws + WS_CTL) + 1024, MISC + 8);
#ifndef PHMASK
#define PHMASK 0xff
#endif
#define REP(k) for (int rep_ = 0; rep_ < 1 + ((DUPMASK >> (k)) & 1); ++rep_)
#define IN(k) (((PHMASK >> (k)) & 1) && lo <= (k) && (k) < hi)
#define SEAM(k) do { if (IN(k) && IN((k) + 1 + ((k) == 2))) { xcd_barrier(bar); if ((DUPMASK >> 15) & 1) { xcd_barrier(bar); xcd_barrier(bar); } } } while (0)

    if (IN(0)) REP(0) { p0_prologue(C, lds); __syncthreads(); }
    SEAM(0);
    if (IN(1)) REP(1) {
        sample_gemm(C.XB + (size_t)MP * DM, C.WinT, NP / 32, C.bid, C.G, C.wid, C.lane, lds, [&](int row, int col, float a) {
            const int m = MP + row, t = row & 3, b = row >> 2;
            const float v = a;
            C.PJ[(size_t)m * NP + col] = f2bf((col >= C_Q && col < C_GN) ? v * QSCALE : v);
            if (col >= C_KV) { const int c = col - C_KV; if (c < 512) C.out[O_KVS + (size_t)row * 512 + c] = v; else C.out[O_WINS + ((size_t)b * 512 + 508 + t) * 256 + (c - 512)] = v; }
            else if (col < ZW && t == 3) C.out[O_SHS + (size_t)b * ZW + col] = v;
        });
        pg8::Gemm g{C.XB, C.WinT, MP, NP, DM}; pg8::StaticOrder S; S.init(MP, NP, C.G, C.bid);
        pg8::EpiIn E{C.PJ, C.RS, C.out};
        pg8::gemm_phase<pg8::EpiIn, pg8::StaticOrder, true, true>(lds, g, S, E);
        __syncthreads();
    }
    SEAM(1);
    if (IN(2)) { p2_rwkv_chunks(C, lds);
#if (DUPMASK >> 8) & 1
        p2_rwkv_chunks(C, lds);
#endif
        p2_compress_prompt(C, lds, C.bid, C.G);
    }
    SEAM(2);
    if (IN(4)) { p4_attention(C, lds); }
    if (IN(5)) { p5_sample_attention(C, lds); }
    SEAM(5);
    if (IN(6)) REP(5) {
        sample_gemm(C.MIX + (size_t)MP * DM, C.WoutT, DM / 32, C.bid, C.G, C.wid, C.lane, lds, [&](int row, int col, float a) {
            C.out[O_YS + (size_t)row * DM + col] = C.xs[(size_t)row * DM + col] + a;
        });
        pg8::Gemm g{C.MIX, C.WoutT, MP, DM, DM}; pg8::StaticOrder S; S.init(MP, DM, C.G, C.bid);
        pg8::EpiOut E{C.XB, (bf16_t*)(C.ws + WS_YB), C.RS};
        pg8::gemm_phase<pg8::EpiOut, pg8::StaticOrder, true, true>(lds, g, S, E);
        __syncthreads();
    }
    SEAM(6);
    if (IN(7)) { p6_final_norm(C); }
#undef IN
#undef SEAM
}

extern "C" void kernel_launch(void* const* d_in, const int* in_sizes, int n_in, void* d_out, int out_size, void* d_ws, size_t ws_size, hipStream_t stream) {
    static int grid = 0;
    if (grid == 0) {
        if (n_in != 23 || (size_t)out_size != O_END || ws_size < WS_END) { fprintf(stderr, "kernel_launch: unexpected shapes: n_in %d out %d ws %zu\n", n_in, out_size, ws_size); grid = -1; return; }
        int dev = 0, cus = 0, per_cu = 0;
        if (hipGetDevice(&dev) != hipSuccess || hipDeviceGetAttribute(&cus, hipDeviceAttributeMultiprocessorCount, dev) != hipSuccess) { grid = -1; return; }
        if (hipFuncSetAttribute((const void*)fwd, hipFuncAttributeMaxDynamicSharedMemorySize, LDS_BYTES) != hipSuccess) { fprintf(stderr, "kernel_launch: hipFuncSetAttribute failed\n"); grid = -1; return; }
        if (hipOccupancyMaxActiveBlocksPerMultiprocessor(&per_cu, (const void*)fwd, 512, LDS_BYTES) != hipSuccess || per_cu < 1) fprintf(stderr, "kernel_launch: occupancy query says %d\n", per_cu);
        (void)hipGetLastError();
        grid = cus;
    }
    if (grid < 0) return;
    (void)hipMemsetAsync((char*)d_ws + WS_CTL, 0, CTL_BYTES, stream);
    Args a{};
    for (int i = 0; i < 23; ++i) a.in[i] = d_in[i];
    a.out = (float*)d_out; a.ws = (unsigned char*)d_ws;
    constexpr int NL = MK_N_LAUNCHES;
    static_assert(NL == 1 || NL == N_PHASES, "MK_N_LAUNCHES is 1 or 8");
    for (int li = 0; li < NL; ++li) {
        a.ph_lo = (NL == 1) ? 0 : li; a.ph_hi = (NL == 1) ? N_PHASES : li + 1;
        hipLaunchKernelGGL(fwd, dim3(grid), dim3(512), LDS_BYTES, stream, a);
        const hipError_t le = hipPeekAtLastError();
        if (le != hipSuccess) { fprintf(stderr, "kernel_launch: launch %d failed: %s\n", li, hipGetErrorName(le)); break; }
    }
}
```
